# Optimizing an MI355X kernel written in HIP

```python
import jax, jax.numpy as jnp
from jax import lax
import numpy as np

D_MODEL = 1024
BATCH = 8
SEQ = 2048
DEPTH = 4
DEC_BATCH = 128
DEC_SEQ = 8
PAST_LEN = 16384
PAGE_SIZE = 128

A_WIDTH = D_MODEL // 2
A_HEAD = 64
A_HEADS = A_WIDTH // A_HEAD
A_W_RANK = 64
A_A_RANK = 64
A_G_RANK = 128
A_COLS = 3 * A_WIDTH + A_W_RANK + A_A_RANK + A_G_RANK
GN_EPS = 64e-5
B_WIDTH = D_MODEL // 2
POOL_WINDOWS = (2, 4, 8, 16)
B_GROUPS = len(POOL_WINDOWS)
B_GROUP = B_WIDTH // B_GROUPS
POOL_BUF = max(POOL_WINDOWS) - 1
B_COLS = B_WIDTH
C_WIDTH = D_MODEL // 2
C_HEAD = 128
C_HEADS = C_WIDTH // C_HEAD
CONV_W = 4
CHUNK = 64
C_COLS = 4 * C_WIDTH + 2 * C_HEADS
N_MEM = 256
M_HEADS = 4
M_HEAD = 64
M_WIDTH = M_HEADS * M_HEAD
M_COLS = M_WIDTH
N_BRANCH = 4
G_COLS = N_BRANCH * D_MODEL
N_IN = A_COLS + B_COLS + C_COLS + M_COLS + G_COLS
BR_WIDTH = A_WIDTH + B_WIDTH + C_WIDTH + M_WIDTH
D_FF = 2 * D_MODEL
ALPHA = (2.0 * DEPTH) ** 0.25
BETA = (8.0 * DEPTH) ** -0.25
LN_EPS = 1e-5
F32 = jnp.float32

kernel_name = 'hybrid_rwkv7_pool_gdn_memory_decoder'


def layer_norm(x, g, b):
    xf = x.astype(F32)
    mu = jnp.mean(xf, axis=-1, keepdims=True)
    var = jnp.mean(jnp.square(xf - mu), axis=-1, keepdims=True)
    return ((xf - mu) * lax.rsqrt(var + LN_EPS) * g.astype(F32) + b.astype(F32)).astype(x.dtype)


def l2_normalize(x):
    xf = x.astype(F32)
    return xf * lax.rsqrt(jnp.sum(xf * xf, axis=-1, keepdims=True) + 1e-12)


def swiglu(x, w_in, w_out):
    gate, up = jnp.split(x @ w_in, 2, axis=-1)
    return (jax.nn.silu(gate) * up) @ w_out


def rwkv7_branch(pa, shift_prev, s0, mu, w0, w_up, a0, a_up, g_up, k_k, k_a, r_k, gn_w, gn_b):
    bsz, seq, _ = pa.shape
    prev = jnp.concatenate([shift_prev[:, None, :], pa[:, :-1]], axis=1)
    xm = pa + (prev - pa) * mu
    r, k, v, xw, xa, xg = jnp.split(
        xm, [A_WIDTH, 2 * A_WIDTH, 3 * A_WIDTH, 3 * A_WIDTH + A_W_RANK, 3 * A_WIDTH + A_W_RANK + A_A_RANK], axis=-1)
    z = (w0 + jnp.tanh(xw) @ w_up).astype(F32)
    decay = jnp.exp(-jnp.exp(-jax.nn.softplus(-z) - 0.5))
    a = jax.nn.sigmoid((a0 + xa @ a_up).astype(F32))
    g = jax.nn.sigmoid(xg) @ g_up
    heads = lambda t: t.astype(F32).reshape(bsz, seq, A_HEADS, A_HEAD)
    kk = l2_normalize(heads(k * k_k))
    k = heads(k * (1.0 + (a - 1.0) * k_a))
    r, v, decay, a = heads(r), heads(v), heads(decay), heads(a)

    def step(s, inp):
        r_t, w_t, k_t, v_t, kk_t, a_t = inp
        sa = jnp.einsum('bhvk,bhk->bhv', s, kk_t)
        s = (s * w_t[:, :, None, :] - sa[..., None] * (kk_t * a_t)[:, :, None, :]
             + v_t[..., None] * k_t[:, :, None, :])
        return s, jnp.einsum('bhvk,bhk->bhv', s, r_t)

    xs = tuple(jnp.moveaxis(t, 1, 0) for t in (r, decay, k, v, kk, a))
    s_new, y = lax.scan(step, s0.astype(F32), xs)
    y = jnp.moveaxis(y, 0, 1)
    mean = jnp.mean(y, axis=-1, keepdims=True)
    var = jnp.mean(jnp.square(y - mean), axis=-1, keepdims=True)
    y = ((y - mean) * lax.rsqrt(var + GN_EPS)).reshape(bsz, seq, A_WIDTH) * gn_w + gn_b
    bonus = jnp.sum(r * k * r_k.astype(F32), axis=-1, keepdims=True) * v
    out = (y + bonus.reshape(bsz, seq, A_WIDTH)) * g
    return out.astype(pa.dtype), pa[:, -1], s_new.astype(s0.dtype)


def pool_branch(pb, buf, pool_w, pool_scale, pos0):
    bsz, seq, _ = pb.shape
    ext = jnp.concatenate([buf, pb], axis=1)
    cs = jnp.pad(jnp.cumsum(ext.astype(F32), axis=1), ((0, 0), (1, 0), (0, 0)))
    t = jnp.arange(seq)
    means = []
    for j, w in enumerate(POOL_WINDOWS):
        sl = slice(j * B_GROUP, (j + 1) * B_GROUP)
        hi = cs[:, POOL_BUF + 1:POOL_BUF + 1 + seq, sl]
        lo = cs[:, POOL_BUF + 1 - w:POOL_BUF + 1 - w + seq, sl]
        count = jnp.minimum(pos0 + t + 1, w).astype(F32)[None, :, None]
        means.append((hi - lo) / count)
    pooled = jnp.concatenate(means, axis=-1) - pb.astype(F32)
    out = jnp.einsum('blgc,gcd->blgd', pooled.reshape(bsz, seq, B_GROUPS, B_GROUP), pool_w.astype(F32))
    out = out.reshape(bsz, seq, B_WIDTH) * pool_scale
    return out.astype(pb.dtype), ext[:, -POOL_BUF:]


def gated_delta_chunked(q, k, v, beta, g, s0):
    bsz, seq, nh, dk = q.shape
    pad = (-seq) % CHUNK
    n = (seq + pad) // CHUNK

    def to_blocks(t):
        t = jnp.pad(t.astype(F32), [(0, 0), (0, pad)] + [(0, 0)] * (t.ndim - 2))
        t = t.reshape((bsz, n, CHUNK) + t.shape[2:])
        return jnp.moveaxis(t, (1, 3), (0, 2))

    qb, kb, vb, bb, gb = to_blocks(q), to_blocks(k), to_blocks(v), to_blocks(beta), to_blocks(g)
    cum = jnp.cumsum(gb, axis=-1)
    incl = jnp.tril(jnp.ones((CHUNK, CHUNK), dtype=bool))
    strict = jnp.tril(jnp.ones((CHUNK, CHUNK), dtype=bool), -1)
    diff = cum[..., :, None] - cum[..., None, :]
    decay = jnp.where(incl, jnp.exp(jnp.where(incl, diff, 0.0)), 0.0)
    k_beta = kb * bb[..., None]
    lmat = jnp.where(strict, jnp.einsum('nbhcd,nbhsd->nbhcs', k_beta, kb) * decay, 0.0)
    eye = jnp.eye(CHUNK, dtype=F32)
    tmat = lax.linalg.triangular_solve(eye + lmat, jnp.broadcast_to(eye, lmat.shape),
                                       left_side=True, lower=True, unit_diagonal=True)
    u = tmat @ (vb * bb[..., None])
    w = tmat @ (k_beta * jnp.exp(cum)[..., None])
    aqk = jnp.einsum('nbhcd,nbhsd->nbhcs', qb, kb) * decay
    g_last = cum[..., -1]
    k_dec = kb * jnp.exp(g_last[..., None] - cum)[..., None]
    q_dec = qb * jnp.exp(cum)[..., None]

    def step(s, inp):
        u_i, w_i, a_i, qd_i, kd_i, gl_i = inp
        v_new = u_i - w_i @ s
        o = qd_i @ s + a_i @ v_new
        s = s * jnp.exp(gl_i)[..., None, None] + jnp.einsum('bhcd,bhce->bhde', kd_i, v_new)
        return s, o

    s_new, o = lax.scan(step, s0, (u, w, aqk, q_dec, k_dec, g_last))
    o = jnp.moveaxis(o, (0, 2), (1, 3)).reshape(bsz, n * CHUNK, nh, vb.shape[-1])[:, :seq]
    return o, s_new


def delta_branch(pc, conv_buf, s0, conv_w, a_log, dt_bias, norm_w):
    bsz, seq, _ = pc.shape
    qkv, zg, b, a = jnp.split(pc, [3 * C_WIDTH, 4 * C_WIDTH, 4 * C_WIDTH + C_HEADS], axis=-1)
    ext = jnp.concatenate([conv_buf, qkv], axis=1)
    conv = ext[:, 0:seq] * conv_w[0]
    for j in range(1, CONV_W):
        conv = conv + ext[:, j:j + seq] * conv_w[j]
    q, k, v = jnp.split(jax.nn.silu(conv), 3, axis=-1)
    heads = lambda t: t.reshape(bsz, seq, C_HEADS, C_HEAD)
    q = l2_normalize(heads(q)) * C_HEAD ** -0.5
    k = l2_normalize(heads(k))
    v = heads(v).astype(F32)
    beta = jax.nn.sigmoid(b.astype(F32))
    g = -jnp.exp(a_log.astype(F32)) * jax.nn.softplus(a.astype(F32) + dt_bias)
    o, s_new = gated_delta_chunked(q, k, v, beta, g, s0.astype(F32))
    o = o * lax.rsqrt(jnp.mean(o * o, axis=-1, keepdims=True) + 1e-6) * norm_w
    o = o * jax.nn.silu(heads(zg).astype(F32))
    return o.reshape(bsz, seq, C_WIDTH).astype(pc.dtype), ext[:, -(CONV_W - 1):], s_new.astype(s0.dtype)


def memory_attention(pm, mem_k, mem_v):
    bsz, seq, _ = pm.shape
    q = pm.reshape(bsz, seq, M_HEADS, M_HEAD)
    s = jnp.einsum('blhd,bmhd->bhlm', q, mem_k).astype(F32) * M_HEAD ** -0.5
    p = jax.nn.softmax(s, axis=-1)
    o = jnp.einsum('bhlm,bmhd->blhd', p.astype(mem_v.dtype), mem_v)
    return o.reshape(bsz, seq, M_WIDTH)


def token_mixing(h, mem_k, mem_v, shift, s_rwkv, pool_buf, conv_buf, s_delta, p, pos0):
    bsz, seq, _ = h.shape
    proj = h @ p['w_in']
    pa, pb, pc, pm, pg = jnp.split(
        proj, [A_COLS, A_COLS + B_COLS, A_COLS + B_COLS + C_COLS, A_COLS + B_COLS + C_COLS + M_COLS], axis=-1)
    oa, shift_new, s_rwkv_new = rwkv7_branch(
        pa, shift, s_rwkv, p['rwkv_mu'], p['rwkv_w0'], p['rwkv_w_up'], p['rwkv_a0'], p['rwkv_a_up'],
        p['rwkv_g_up'], p['rwkv_k_k'], p['rwkv_k_a'], p['rwkv_r_k'], p['rwkv_gn_w'], p['rwkv_gn_b'])
    ob, pool_new = pool_branch(pb, pool_buf, p['pool_w'], p['pool_scale'], pos0)
    oc, conv_new, s_delta_new = delta_branch(
        pc, conv_buf, s_delta, p['delta_conv_w'], p['delta_a_log'], p['delta_dt_bias'], p['delta_norm_w'])
    om = memory_attention(pm, mem_k, mem_v)
    gates = jax.nn.sigmoid(pg.reshape(bsz, seq, N_BRANCH, D_MODEL).astype(F32)).astype(h.dtype)
    wb = p['w_branch']
    bounds = (0, A_WIDTH, A_WIDTH + B_WIDTH, A_WIDTH + B_WIDTH + C_WIDTH, BR_WIDTH)
    merged = None
    for i, o in enumerate((oa, ob, oc, om)):
        term = gates[:, :, i] * (o @ wb[bounds[i]:bounds[i + 1]])
        merged = term if merged is None else merged + term
    return merged @ p['w_out'], (shift_new, s_rwkv_new, pool_new, conv_new, s_delta_new)


def run_trunk(x, mem_k, mem_v, shift, s_rwkv, pool_buf, conv_buf, s_delta, params, pos0):
    new = []
    for l in range(DEPTH):
        p = params[l]
        x = layer_norm(ALPHA * x + 0.5 * swiglu(x, p['ffn1_w_in'], p['ffn1_w_out']), p['ln_g'][0], p['ln_b'][0])
        mix, st = token_mixing(x, mem_k[l], mem_v[l], shift[l], s_rwkv[l], pool_buf[l], conv_buf[l],
                               s_delta[l], p, pos0)
        x = layer_norm(ALPHA * x + mix, p['ln_g'][1], p['ln_b'][1])
        x = layer_norm(ALPHA * x + 0.5 * swiglu(x, p['ffn2_w_in'], p['ffn2_w_out']), p['ln_g'][2], p['ln_b'][2])
        new.append(st)
    shift_n, rwkv_n, pool_n, conv_n, delta_n = [jnp.stack([st[i] for st in new]) for i in range(5)]
    return x, shift_n, rwkv_n, pool_n, conv_n, delta_n


def setup_inputs(seed: int = 0) -> dict:
    key = jax.random.key(seed)
    keys = iter(jax.random.split(key, 64))

    def nrm(shape, scale):
        return scale * jax.random.normal(next(keys), shape, F32)

    def unif(shape, lo, hi):
        return jax.random.uniform(next(keys), shape, F32, lo, hi)

    L = DEPTH
    return {
        'x_prompt': nrm((BATCH, SEQ, D_MODEL), 1.0),
        'x_sample': nrm((DEC_BATCH, DEC_SEQ, D_MODEL), 1.0),
        'mem_prompt': nrm((BATCH, N_MEM, D_MODEL), 1.0),
        'cache_mem_k': nrm((L, DEC_BATCH, N_MEM, M_HEADS, M_HEAD), 1.0),
        'cache_mem_v': nrm((L, DEC_BATCH, N_MEM, M_HEADS, M_HEAD), 1.0),
        'state_rwkv': nrm((L, DEC_BATCH, A_HEADS, A_HEAD, A_HEAD), 0.1),
        'state_rwkv_shift': nrm((L, DEC_BATCH, A_COLS), 1.0),
        'state_pool': nrm((L, DEC_BATCH, POOL_BUF, B_WIDTH), 1.0),
        'state_delta': nrm((L, DEC_BATCH, C_HEADS, C_HEAD, C_HEAD), 0.1),
        'state_delta_conv': nrm((L, DEC_BATCH, CONV_W - 1, 3 * C_WIDTH), 1.0),
        'w_in': nrm((L, D_MODEL, N_IN), D_MODEL ** -0.5),
        'rwkv_mu': unif((L, A_COLS), 0.0, 1.0),
        'rwkv_w0': unif((L, A_WIDTH), -5.0, 1.0),
        'rwkv_w_up': nrm((L, A_W_RANK, A_WIDTH), 0.1),
        'rwkv_a0': nrm((L, A_WIDTH), 0.1),
        'rwkv_a_up': nrm((L, A_A_RANK, A_WIDTH), A_A_RANK ** -0.5),
        'rwkv_g_up': nrm((L, A_G_RANK, A_WIDTH), A_G_RANK ** -0.5),
        'rwkv_k_k': 0.85 + nrm((L, A_WIDTH), 0.02),
        'rwkv_k_a': 1.0 + nrm((L, A_WIDTH), 0.02),
        'rwkv_r_k': nrm((L, A_HEADS, A_HEAD), 0.1),
        'rwkv_gn_w': 1.0 + nrm((L, A_WIDTH), 0.02),
        'rwkv_gn_b': nrm((L, A_WIDTH), 0.02),
        'pool_w': nrm((L, B_GROUPS, B_GROUP, B_GROUP), B_GROUP ** -0.5),
        'pool_scale': 1.0 + nrm((L, B_WIDTH), 0.02),
        'delta_conv_w': nrm((L, CONV_W, 3 * C_WIDTH), 0.5),
        'delta_a_log': jnp.log(unif((L, C_HEADS), 1.0, 16.0)),
        'delta_dt_bias': nrm((L, C_HEADS), 0.1),
        'delta_norm_w': 1.0 + nrm((L, C_HEAD), 0.02),
        'mem_w_kv': nrm((L, D_MODEL, 2 * M_WIDTH), D_MODEL ** -0.5),
        'w_branch': nrm((L, BR_WIDTH, D_MODEL), BETA * A_WIDTH ** -0.5),
        'w_out': nrm((L, D_MODEL, D_MODEL), BETA * D_MODEL ** -0.5),
        'ffn1_w_in': nrm((L, D_MODEL, 2 * D_FF), D_MODEL ** -0.5),
        'ffn1_w_out': nrm((L, D_FF, D_MODEL), BETA * D_FF ** -0.5),
        'ffn2_w_in': nrm((L, D_MODEL, 2 * D_FF), D_MODEL ** -0.5),
        'ffn2_w_out': nrm((L, D_FF, D_MODEL), BETA * D_FF ** -0.5),
        'ln_g': 1.0 + nrm((L, 3, D_MODEL), 0.02),
        'ln_b': nrm((L, 3, D_MODEL), 0.02),
    }


def reference(x_prompt, x_sample, mem_prompt, cache_mem_k, cache_mem_v, state_rwkv, state_rwkv_shift,
              state_pool, state_delta, state_delta_conv, w_in, rwkv_mu, rwkv_w0, rwkv_w_up, rwkv_a0,
              rwkv_a_up, rwkv_g_up, rwkv_k_k, rwkv_k_a, rwkv_r_k, rwkv_gn_w, rwkv_gn_b, pool_w, pool_scale,
              delta_conv_w, delta_a_log, delta_dt_bias, delta_norm_w, mem_w_kv, w_branch, w_out,
              ffn1_w_in, ffn1_w_out, ffn2_w_in, ffn2_w_out, ln_g, ln_b):
    params = [dict(w_in=w_in[l], rwkv_mu=rwkv_mu[l], rwkv_w0=rwkv_w0[l], rwkv_w_up=rwkv_w_up[l],
                   rwkv_a0=rwkv_a0[l], rwkv_a_up=rwkv_a_up[l], rwkv_g_up=rwkv_g_up[l], rwkv_k_k=rwkv_k_k[l],
                   rwkv_k_a=rwkv_k_a[l], rwkv_r_k=rwkv_r_k[l], rwkv_gn_w=rwkv_gn_w[l], rwkv_gn_b=rwkv_gn_b[l],
                   pool_w=pool_w[l], pool_scale=pool_scale[l], delta_conv_w=delta_conv_w[l],
                   delta_a_log=delta_a_log[l], delta_dt_bias=delta_dt_bias[l], delta_norm_w=delta_norm_w[l],
                   w_branch=w_branch[l], w_out=w_out[l], ffn1_w_in=ffn1_w_in[l], ffn1_w_out=ffn1_w_out[l],
                   ffn2_w_in=ffn2_w_in[l], ffn2_w_out=ffn2_w_out[l], ln_g=ln_g[l], ln_b=ln_b[l])
              for l in range(DEPTH)]
    bp = x_prompt.shape[0]
    n_mem = mem_prompt.shape[1]
    dt = x_prompt.dtype
    mem_kv = jnp.einsum('bmd,lde->lbme', mem_prompt, mem_w_kv)
    p_mem_k = mem_kv[..., :M_WIDTH].reshape(DEPTH, bp, n_mem, M_HEADS, M_HEAD)
    p_mem_v = mem_kv[..., M_WIDTH:].reshape(DEPTH, bp, n_mem, M_HEADS, M_HEAD)
    y_prompt, p_rwkv_shift, p_rwkv, p_pool, p_delta_conv, p_delta = run_trunk(
        x_prompt, p_mem_k, p_mem_v,
        jnp.zeros((DEPTH, bp, A_COLS), dt),
        jnp.zeros((DEPTH, bp, A_HEADS, A_HEAD, A_HEAD), dt),
        jnp.zeros((DEPTH, bp, POOL_BUF, B_WIDTH), dt),
        jnp.zeros((DEPTH, bp, CONV_W - 1, 3 * C_WIDTH), dt),
        jnp.zeros((DEPTH, bp, C_HEADS, C_HEAD, C_HEAD), dt),
        params, 0)
    y_sample, s_rwkv_shift, s_rwkv, s_pool, s_delta_conv, s_delta = run_trunk(
        x_sample, cache_mem_k, cache_mem_v, state_rwkv_shift, state_rwkv, state_pool, state_delta_conv,
        state_delta, params, PAST_LEN)
    return (y_prompt, y_sample, p_rwkv, p_rwkv_shift, p_pool, p_delta, p_delta_conv, p_mem_k, p_mem_v,
            s_rwkv, s_rwkv_shift, s_pool, s_delta, s_delta_conv)
```

```cpp
#include <hip/hip_runtime.h>
#include <hip/hip_cooperative_groups.h>
#include <stdint.h>
#include <cstdio>
namespace cg = cooperative_groups;

typedef unsigned short bf16_t;
typedef short bf16x8 __attribute__((ext_vector_type(8)));
typedef float f32x4 __attribute__((ext_vector_type(4)));
typedef unsigned u32x4 __attribute__((ext_vector_type(4)));

#ifndef MULTI_LAUNCH
#define MULTI_LAUNCH 0
#endif

constexpr int NTOK = 17408;
constexpr int TPROMPT = 16384;
constexpr int PW = 4736;
constexpr int PB = 1792, PC = 2304, PM = 4352, PBA = 4608;
constexpr float ALPHA = 1.6817928305074292f;
constexpr int NPH_LAYER = 13;
constexpr int NPHASES = 1 + 4 * NPH_LAYER;

constexpr size_t O_YP = 0;
constexpr size_t O_YS = O_YP + (size_t)8 * 2048 * 1024;
constexpr size_t O_PRWKV = O_YS + (size_t)128 * 8 * 1024;
constexpr size_t O_PSHIFT = O_PRWKV + (size_t)4 * 8 * 8 * 4096;
constexpr size_t O_PPOOL = O_PSHIFT + (size_t)4 * 8 * 1792;
constexpr size_t O_PDELTA = O_PPOOL + (size_t)4 * 8 * 15 * 512;
constexpr size_t O_PCONV = O_PDELTA + (size_t)4 * 8 * 4 * 16384;
constexpr size_t O_PMK = O_PCONV + (size_t)4 * 8 * 3 * 1536;
constexpr size_t O_PMV = O_PMK + (size_t)4 * 8 * 256 * 256;
constexpr size_t O_SRWKV = O_PMV + (size_t)4 * 8 * 256 * 256;
constexpr size_t O_SSHIFT = O_SRWKV + (size_t)4 * 128 * 8 * 4096;
constexpr size_t O_SPOOL = O_SSHIFT + (size_t)4 * 128 * 1792;
constexpr size_t O_SDELTA = O_SPOOL + (size_t)4 * 128 * 15 * 512;
constexpr size_t O_SCONV = O_SDELTA + (size_t)4 * 128 * 4 * 16384;

constexpr size_t al(size_t x) { return (x + 255) & ~(size_t)255; }
constexpr size_t OFF_WF1I = 0;
constexpr size_t OFF_WF1O = OFF_WF1I + al((size_t)4096 * 1024 * 2);
constexpr size_t OFF_WF2I = OFF_WF1O + al((size_t)1024 * 2048 * 2);
constexpr size_t OFF_WF2O = OFF_WF2I + al((size_t)4096 * 1024 * 2);
constexpr size_t OFF_WP = OFF_WF2O + al((size_t)1024 * 2048 * 2);
constexpr size_t OFF_WG = OFF_WP + al((size_t)PW * 1024 * 2);
constexpr size_t OFF_WB = OFF_WG + al((size_t)4096 * 1024 * 2);
constexpr size_t OFF_WO = OFF_WB + al((size_t)1024 * 1792 * 2);
constexpr size_t OFF_POOLT = OFF_WO + al((size_t)1024 * 1024 * 2);
constexpr size_t OFF_WUP = OFF_POOLT + al((size_t)4 * 128 * 128 * 2);
constexpr size_t OFF_AUP = OFF_WUP + al((size_t)512 * 64 * 2);
constexpr size_t OFF_GUP = OFF_AUP + al((size_t)512 * 64 * 2);
constexpr size_t OFF_WKV = OFF_GUP + al((size_t)512 * 128 * 2);
constexpr size_t OFF_MEMB = OFF_WKV + al((size_t)4 * 512 * 1024 * 2);
constexpr size_t OFF_KP = OFF_MEMB + al((size_t)2048 * 1024 * 2);
constexpr size_t OFF_VTP = OFF_KP + al((size_t)4 * 8 * 4 * 16384 * 2);
constexpr size_t OFF_KS = OFF_VTP + al((size_t)4 * 8 * 4 * 16384 * 2);
constexpr size_t OFF_VTS = OFF_KS + al((size_t)128 * 4 * 16384 * 2);
constexpr size_t OFF_XB = OFF_VTS + al((size_t)128 * 4 * 16384 * 2);
constexpr size_t OFF_Y = OFF_XB + al((size_t)NTOK * 1024 * 2);
constexpr size_t OFF_P = OFF_Y + al((size_t)NTOK * 1024 * 4);
constexpr size_t OFF_BO = OFF_P + al((size_t)NTOK * PW * 2);
constexpr size_t OFF_MERGED = OFF_BO + al((size_t)NTOK * 1792 * 2);
constexpr size_t OFF_POOLED = OFF_MERGED + al((size_t)NTOK * 1024 * 2);
constexpr size_t OFF_RW = OFF_POOLED + al((size_t)NTOK * 512 * 2);
constexpr size_t OFF_RKK = OFF_RW + al((size_t)NTOK * 512 * 4);
constexpr size_t OFF_RKA = OFF_RKK + al((size_t)NTOK * 512 * 2);
constexpr size_t OFF_RKP = OFF_RKA + al((size_t)NTOK * 512 * 2);
constexpr size_t OFF_RR = OFF_RKP + al((size_t)NTOK * 512 * 2);
constexpr size_t OFF_RV = OFF_RR + al((size_t)NTOK * 512 * 2);
constexpr size_t OFF_RG = OFF_RV + al((size_t)NTOK * 512 * 2);
constexpr size_t OFF_RC = OFF_RG + al((size_t)NTOK * 512 * 2);
constexpr size_t OFF_DQ = OFF_RC + al((size_t)NTOK * 8 * 4);
constexpr size_t OFF_DK = OFF_DQ + al((size_t)NTOK * 512 * 2);
constexpr size_t OFF_DV = OFF_DK + al((size_t)NTOK * 512 * 2);
constexpr size_t OFF_DSC = OFF_DV + al((size_t)NTOK * 512 * 2);
constexpr size_t OFF_BAR = OFF_DSC + al((size_t)NTOK * 4 * 2 * 4);
constexpr size_t OFF_CNT = OFF_BAR + al((size_t)3456 * 4);
constexpr size_t OFF_SZ = OFF_CNT + 1024;
constexpr size_t OFF_G = OFF_SZ + al((size_t)NTOK * 512 * 2);
constexpr size_t WS_TOTAL = OFF_G + al((size_t)NTOK * 4096 * 2);

struct Params { const float* in[37]; float* out; unsigned char* ws; };
typedef const __attribute__((address_space(4))) Params* KP;

enum { I_XP = 0, I_XS, I_MEMP, I_CMK, I_CMV, I_SRWKV, I_SSHIFT, I_SPOOL, I_SDELTA, I_SCONV, I_WIN, I_MU, I_W0, I_WUP, I_A0,
       I_AUP, I_GUP, I_KK, I_KA, I_RK, I_GNW, I_GNB, I_POOLW, I_POOLS, I_CONVW, I_ALOG, I_DTB, I_NORMW, I_WKV, I_WBR,
       I_WOUT, I_F1I, I_F1O, I_F2I, I_F2O, I_LNG, I_LNB };

__device__ __forceinline__ float bf2f(bf16_t h) { return __uint_as_float(((unsigned)h) << 16); }
__device__ __forceinline__ bf16_t f2bf(float f) { unsigned u = __float_as_uint(f); u += 0x7fffu + ((u >> 16) & 1u); return (bf16_t)(u >> 16); }
typedef float f32x2_ __attribute__((ext_vector_type(2)));
typedef __bf16 bf16x2_ __attribute__((ext_vector_type(2)));
__device__ __forceinline__ unsigned pack2(float a, float b) {
    const f32x2_ v = {a, b};
    const bf16x2_ r = __builtin_convertvector(v, bf16x2_);
    return __builtin_bit_cast(unsigned, r);
}
__device__ __forceinline__ float lo2f(unsigned u) { return __uint_as_float(u << 16); }
__device__ __forceinline__ float hi2f(unsigned u) { return __uint_as_float(u & 0xffff0000u); }
__device__ __forceinline__ float sigmoid_(float x) { return __builtin_amdgcn_rcpf(1.f + __expf(-x)); }
__device__ __forceinline__ float silu_(float x) { return x * __builtin_amdgcn_rcpf(1.f + __expf(-x)); }
__device__ __forceinline__ float softplus_(float x) { return fmaxf(x, 0.f) + __logf(1.f + __expf(-fabsf(x))); }
__device__ __forceinline__ float tanh_(float x) { return 1.f - 2.f * __builtin_amdgcn_rcpf(1.f + __expf(2.f * x)); }

__device__ __forceinline__ int tidx() { int t = threadIdx.x; asm volatile("" : "+v"(t)); return t; }
template <int CTRL> __device__ __forceinline__ float dpp_mov(float v) {
    return __int_as_float(__builtin_amdgcn_update_dpp(0, __float_as_int(v), CTRL, 0xf, 0xf, true));
}
__device__ __forceinline__ float red16(float v) {
    v += dpp_mov<0xB1>(v);
    v += dpp_mov<0x4E>(v);
    v += dpp_mov<0x141>(v);
    v += dpp_mov<0x140>(v);
    return v;
}
__device__ __forceinline__ float wave_sum(float v) {
    v = red16(v);
    v += __shfl_xor(v, 16);
    v += __shfl_xor(v, 32);
    return v;
}

__device__ __forceinline__ int mapcol(int kind, int n) {
    if (kind == 0) return n;
    if (kind == 1) return (n & 1) * 2048 + (n >> 1);
    if (kind == 2) { if (n < 4352) return n; if (n < 4608) return n + 8; if (n < 4616) return n - 256; return -1; }
    return n + 4616;
}
__device__ __forceinline__ void conv_job(const float* __restrict__ src, int ld, int K, bf16_t* dst, int Ndst, int kind, float* tile) {
    const int tid_ = tidx();
    const int tilesK = K >> 6, ntiles = tilesK * (Ndst >> 6);
    const int tx = tid_ & 63, ty = tid_ >> 6;
    const int tx2 = tid_ & 31, ty2 = tid_ >> 5;
    float r[16];
    int t = blockIdx.x;
    if (t < ntiles) {
        const int tk = t % tilesK, tn = t / tilesK, k0 = tk << 6, n0 = tn << 6;
        const int sc = mapcol(kind, n0 + tx);
#pragma unroll
        for (int i = 0; i < 16; ++i) r[i] = sc >= 0 ? src[(size_t)(k0 + ty + 4 * i) * ld + sc] : 0.f;
    }
    for (; t < ntiles; t += gridDim.x) {
        const int tk = t % tilesK, tn = t / tilesK, k0 = tk << 6, n0 = tn << 6;
#pragma unroll
        for (int i = 0; i < 16; ++i) tile[(ty + 4 * i) * 65 + tx] = r[i];
        __syncthreads();
        const int tnext = t + gridDim.x;
        if (tnext < ntiles) {
            const int tk2 = tnext % tilesK, tn2 = tnext / tilesK, k2 = tk2 << 6, n2 = tn2 << 6;
            const int sc = mapcol(kind, n2 + tx);
#pragma unroll
            for (int i = 0; i < 16; ++i) r[i] = sc >= 0 ? src[(size_t)(k2 + ty + 4 * i) * ld + sc] : 0.f;
        }
#pragma unroll
        for (int i = 0; i < 8; ++i) {
            const int nn = ty2 + 8 * i;
            *(unsigned*)(dst + (size_t)(n0 + nn) * K + k0 + 2 * tx2) = pack2(tile[(2 * tx2) * 65 + nn], tile[(2 * tx2 + 1) * 65 + nn]);
        }
        __syncthreads();
    }
}
__device__ __forceinline__ void convert_layer_weights(KP p, int l, float* tile) {
    unsigned char* ws = p->ws;
    conv_job(p->in[I_F1I] + (size_t)l * 1024 * 4096, 4096, 1024, (bf16_t*)(ws + OFF_WF1I), 4096, 1, tile);
    conv_job(p->in[I_F1O] + (size_t)l * 2048 * 1024, 1024, 2048, (bf16_t*)(ws + OFF_WF1O), 1024, 0, tile);
    conv_job(p->in[I_F2I] + (size_t)l * 1024 * 4096, 4096, 1024, (bf16_t*)(ws + OFF_WF2I), 4096, 1, tile);
    conv_job(p->in[I_F2O] + (size_t)l * 2048 * 1024, 1024, 2048, (bf16_t*)(ws + OFF_WF2O), 1024, 0, tile);
    conv_job(p->in[I_WIN] + (size_t)l * 1024 * 8712, 8712, 1024, (bf16_t*)(ws + OFF_WP), PW, 2, tile);
    conv_job(p->in[I_WIN] + (size_t)l * 1024 * 8712, 8712, 1024, (bf16_t*)(ws + OFF_WG), 4096, 3, tile);
    conv_job(p->in[I_WBR] + (size_t)l * 1792 * 1024, 1024, 1792, (bf16_t*)(ws + OFF_WB), 1024, 0, tile);
    conv_job(p->in[I_WOUT] + (size_t)l * 1024 * 1024, 1024, 1024, (bf16_t*)(ws + OFF_WO), 1024, 0, tile);
    for (int g = 0; g < 4; ++g)
        conv_job(p->in[I_POOLW] + (size_t)(l * 4 + g) * 16384, 128, 128, (bf16_t*)(ws + OFF_POOLT) + g * 16384, 128, 0, tile);
    conv_job(p->in[I_WUP] + (size_t)l * 64 * 512, 512, 64, (bf16_t*)(ws + OFF_WUP), 512, 0, tile);
    conv_job(p->in[I_AUP] + (size_t)l * 64 * 512, 512, 64, (bf16_t*)(ws + OFF_AUP), 512, 0, tile);
    conv_job(p->in[I_GUP] + (size_t)l * 128 * 512, 512, 128, (bf16_t*)(ws + OFF_GUP), 512, 0, tile);
}

__device__ __forceinline__ void phase_init(KP p, float* tile) {
    const int tid_ = tidx();
    unsigned char* ws = p->ws;
    for (int l = 0; l < 4; ++l)
        conv_job(p->in[I_WKV] + (size_t)l * 1024 * 512, 512, 1024, (bf16_t*)(ws + OFF_WKV) + (size_t)l * 512 * 1024, 512, 0, tile);
    const size_t gt = (size_t)blockIdx.x * 256 + tid_, gs = (size_t)gridDim.x * 256;
    {
        float4* X = (float4*)p->out; uint2* xb = (uint2*)(ws + OFF_XB);
        const float4* xp = (const float4*)p->in[I_XP]; const float4* xs = (const float4*)p->in[I_XS];
        const size_t np4 = (size_t)TPROMPT * 256, n4 = (size_t)NTOK * 256;
        for (size_t i0 = gt; i0 < n4; i0 += 4 * gs) {
            float4 v[4];
#pragma unroll
            for (int u = 0; u < 4; ++u) { const size_t i = i0 + u * gs; if (i < n4) v[u] = i < np4 ? xp[i] : xs[i - np4]; }
#pragma unroll
            for (int u = 0; u < 4; ++u) { const size_t i = i0 + u * gs; if (i < n4) { X[i] = v[u]; xb[i] = make_uint2(pack2(v[u].x, v[u].y), pack2(v[u].z, v[u].w)); } }
        }
    }
    {
        const float4* mp = (const float4*)p->in[I_MEMP]; uint2* mb = (uint2*)(ws + OFF_MEMB);
        for (size_t i = gt; i < (size_t)2048 * 256; i += gs) { float4 v = mp[i]; mb[i] = make_uint2(pack2(v.x, v.y), pack2(v.z, v.w)); }
    }
}

constexpr int LDT = 80;
__device__ __forceinline__ void lds_barrier() {
    asm volatile("s_waitcnt lgkmcnt(0)" ::: "memory");
    __builtin_amdgcn_s_barrier();
    asm volatile("" ::: "memory");
}
template <int NT>
__device__ __forceinline__ void gemm_compute(f32x4 (&acc)[4][NT], const bf16_t* sA, const bf16_t* sB, int wr, int wc, int fr, int fq) {
#pragma unroll
    for (int ks = 0; ks < 2; ++ks) {
        bf16x8 a[4], b[NT];
#pragma unroll
        for (int mt = 0; mt < 4; ++mt) a[mt] = *(const bf16x8*)(sA + (wr * 64 + mt * 16 + fr) * LDT + ks * 32 + fq * 8);
#pragma unroll
        for (int nt = 0; nt < NT; ++nt) b[nt] = *(const bf16x8*)(sB + (wc * 16 * NT + nt * 16 + fr) * LDT + ks * 32 + fq * 8);
        __builtin_amdgcn_s_setprio(1);
#pragma unroll
        for (int mt = 0; mt < 4; ++mt)
#pragma unroll
            for (int nt = 0; nt < NT; ++nt)
                acc[mt][nt] = __builtin_amdgcn_mfma_f32_16x16x32_bf16(b[nt], a[mt], acc[mt][nt], 0, 0, 0);
        __builtin_amdgcn_s_setprio(0);
    }
}
template <int NT>
__device__ __forceinline__ void gemm_tile(f32x4 (&acc)[4][NT], const bf16_t* A, int lda, const bf16_t* B, int ldb, int K, bf16_t* sm) {
    const int tid_ = tidx();
    bf16_t* sA = sm; bf16_t* sB = sm + 128 * LDT;
    const int tid = tid_, lane = tid & 63, wid = tid >> 6, wr = wid >> 1, wc = wid & 1;
    const int fr = lane & 15, fq = lane >> 4;
    const int lrow = tid >> 3, lkc = tid & 7;
    const bf16_t* ga = A + (size_t)lrow * lda + lkc * 8;
    const bf16_t* gb = B + (size_t)lrow * ldb + lkc * 8;
    int sbrow[NT];
    const int sbase = (lrow % NT) * 16 + lrow / NT;
#pragma unroll
    for (int i = 0; i < NT; ++i) sbrow[i] = sbase + (NT == 4 ? (i >> 1) * 64 + (i & 1) * 8 : i * 32);
    u32x4 ra0[4], rb0[NT];
#pragma unroll
    for (int i = 0; i < 4; ++i) ra0[i] = *(const u32x4*)(ga + (size_t)(32 * i) * lda);
#pragma unroll
    for (int i = 0; i < NT; ++i) rb0[i] = *(const u32x4*)(gb + (size_t)(32 * i) * ldb);
    const int nk = K >> 6;
    for (int kt = 0; kt < nk; ++kt) {
        lds_barrier();
#pragma unroll
        for (int i = 0; i < 4; ++i) *(u32x4*)(sA + (lrow + 32 * i) * LDT + lkc * 8) = ra0[i];
#pragma unroll
        for (int i = 0; i < NT; ++i) *(u32x4*)(sB + sbrow[i] * LDT + lkc * 8) = rb0[i];
        lds_barrier();
        if (kt + 1 < nk) {
            ga += 64; gb += 64;
#pragma unroll
            for (int i = 0; i < 4; ++i) ra0[i] = *(const u32x4*)(ga + (size_t)(32 * i) * lda);
#pragma unroll
            for (int i = 0; i < NT; ++i) rb0[i] = *(const u32x4*)(gb + (size_t)(32 * i) * ldb);
        }
        __builtin_amdgcn_sched_barrier(0);
        gemm_compute<NT>(acc, sA, sB, wr, wc, fr, fq);
        __builtin_amdgcn_sched_barrier(0);
    }
}
template <int NT> __device__ __forceinline__ void zero_acc(f32x4 (&acc)[4][NT]) {
#pragma unroll
    for (int mt = 0; mt < 4; ++mt)
#pragma unroll
        for (int nt = 0; nt < NT; ++nt) acc[mt][nt] = (f32x4){0.f, 0.f, 0.f, 0.f};
}

template <int NT>
__device__ __forceinline__ void gather_cols(const f32x4 (&acc)[4][NT], int mt, float (&v)[4 * NT]) {
#pragma unroll
    for (int e = 0; e < 4 * NT; ++e) v[e] = acc[mt][e % NT][e / NT];
}
__device__ __forceinline__ void phase_ffn_in(const bf16_t* xb, const bf16_t* W, bf16_t* H, bf16_t* sm) {
    const int tid_ = tidx();
    const int lane = tid_ & 63, wid = tid_ >> 6, wr = wid >> 1, wc = wid & 1, fr = lane & 15, fq = lane >> 4;
    for (int t = blockIdx.x; t < 136 * 32; t += gridDim.x) {
        const int tm = t >> 5, tn = t & 31;
        f32x4 acc[4][4]; zero_acc<4>(acc);
        gemm_tile<4>(acc, xb + (size_t)tm * 128 * 1024, 1024, W + (size_t)tn * 128 * 1024, 1024, 1024, sm);
#pragma unroll
        for (int mt = 0; mt < 4; ++mt) {
            const int row = tm * 128 + wr * 64 + mt * 16 + fr;
            const int hc = tn * 64 + wc * 32 + fq * 8;
            float v[16]; gather_cols<4>(acc, mt, v);
            u32x4 o;
#pragma unroll
            for (int q = 0; q < 4; ++q) o[q] = pack2(silu_(v[4 * q]) * v[4 * q + 1], silu_(v[4 * q + 2]) * v[4 * q + 3]);
            *(u32x4*)(H + (size_t)row * 2048 + hc) = o;
        }
    }
}
template <int NT>
__device__ __forceinline__ void resid_tile(int tm, int col0, const bf16_t* A, int lda, int K, const bf16_t* W, const float* X, float* Y, float scale, bf16_t* sm) {
    const int tid_ = tidx();
    const int lane = tid_ & 63, wid = tid_ >> 6, wr = wid >> 1, wc = wid & 1, fr = lane & 15, fq = lane >> 4;
    f32x4 acc[4][NT]; zero_acc<NT>(acc);
    gemm_tile<NT>(acc, A + (size_t)tm * 128 * lda, lda, W + (size_t)col0 * K, K, K, sm);
#pragma unroll
    for (int mt = 0; mt < 4; ++mt) {
        const int row = tm * 128 + wr * 64 + mt * 16 + fr;
        const int cbase = col0 + wc * 16 * NT + fq * 4 * NT;
        const size_t o = (size_t)row * 1024 + cbase;
#pragma unroll
        for (int q = 0; q < NT; ++q) {
            const float4 xv = *(const float4*)(X + o + 4 * q);
            *(float4*)(Y + o + 4 * q) = make_float4(ALPHA * xv.x + scale * acc[mt][(4 * q) % NT][(4 * q) / NT], ALPHA * xv.y + scale * acc[mt][(4 * q + 1) % NT][(4 * q + 1) / NT],
                                                    ALPHA * xv.z + scale * acc[mt][(4 * q + 2) % NT][(4 * q + 2) / NT], ALPHA * xv.w + scale * acc[mt][(4 * q + 3) % NT][(4 * q + 3) / NT]);
        }
    }
}
__device__ __forceinline__ void phase_gemm_resid(const bf16_t* A, int lda, int K, const bf16_t* W, const float* X, float* Y, float scale, bf16_t* sm) {
    const int G = gridDim.x, NTILES = 136 * 8;
    const int nfull = (NTILES / G) * G;
    for (int t = blockIdx.x; t < nfull; t += G) resid_tile<4>(t >> 3, (t & 7) * 128, A, lda, K, W, X, Y, scale, sm);
    for (int u = blockIdx.x; u < 2 * (NTILES - nfull); u += G) {
        const int t = nfull + (u >> 1);
        resid_tile<2>(t >> 3, (t & 7) * 128 + (u & 1) * 64, A, lda, K, W, X, Y, scale, sm);
    }
}
__device__ __forceinline__ void phase_proj(const bf16_t* xb, const bf16_t* W, bf16_t* P, bf16_t* sm) {
    const int tid_ = tidx();
    const int lane = tid_ & 63, wid = tid_ >> 6, wr = wid >> 1, wc = wid & 1, fr = lane & 15, fq = lane >> 4;
    for (int t = blockIdx.x; t < 136 * 37; t += gridDim.x) {
        const int tm = t / 37, tn = t % 37;
        f32x4 acc[4][4]; zero_acc<4>(acc);
        gemm_tile<4>(acc, xb + (size_t)tm * 128 * 1024, 1024, W + (size_t)tn * 128 * 1024, 1024, 1024, sm);
#pragma unroll
        for (int mt = 0; mt < 4; ++mt) {
            const int row = tm * 128 + wr * 64 + mt * 16 + fr;
            const int cbase = tn * 128 + wc * 64 + fq * 16;
            float v[16]; gather_cols<4>(acc, mt, v);
            u32x4 o0, o1;
#pragma unroll
            for (int q = 0; q < 4; ++q) { o0[q] = pack2(v[2 * q], v[2 * q + 1]); o1[q] = pack2(v[8 + 2 * q], v[8 + 2 * q + 1]); }
            *(u32x4*)(P + (size_t)row * PW + cbase) = o0;
            *(u32x4*)(P + (size_t)row * PW + cbase + 8) = o1;
        }
    }
}
__device__ __forceinline__ void phase_memkv(KP p, bf16_t* sm) {
    const int tid_ = tidx();
    const int lane = tid_ & 63, wid = tid_ >> 6, wr = wid >> 1, wc = wid & 1, fr = lane & 15, fq = lane >> 4;
    const bf16_t* memb = (const bf16_t*)(p->ws + OFF_MEMB);
    const bf16_t* wkv = (const bf16_t*)(p->ws + OFF_WKV);
    bf16_t* Kp = (bf16_t*)(p->ws + OFF_KP); bf16_t* Vtp = (bf16_t*)(p->ws + OFF_VTP);
    for (int t = blockIdx.x; t < 4 * 16 * 4; t += gridDim.x) {
        const int l = t >> 6, tm = (t >> 2) & 15, tn = t & 3;
        f32x4 acc[4][4]; zero_acc<4>(acc);
        gemm_tile<4>(acc, memb + (size_t)tm * 128 * 1024, 1024, wkv + ((size_t)l * 512 + tn * 128) * 1024, 1024, 1024, sm);
#pragma unroll
        for (int mt = 0; mt < 4; ++mt) {
            const int row = tm * 128 + wr * 64 + mt * 16 + fr;
            const int cbase = tn * 128 + wc * 64 + fq * 16;
            float v[16]; gather_cols<4>(acc, mt, v);
            const int b = row >> 8, key = row & 255;
            const int c2 = cbase & 255, h = c2 >> 6, d0 = c2 & 63;
            float* dst = p->out + (tn < 2 ? O_PMK : O_PMV) + ((size_t)l * 2048 + row) * 256 + c2;
#pragma unroll
            for (int q = 0; q < 4; ++q) *(float4*)(dst + 4 * q) = make_float4(v[4 * q], v[4 * q + 1], v[4 * q + 2], v[4 * q + 3]);
            const size_t hb = ((size_t)((l * 8 + b) * 4 + h)) * 16384;
            if (tn < 2) {
                u32x4 o0, o1;
#pragma unroll
                for (int q = 0; q < 4; ++q) { o0[q] = pack2(v[2 * q], v[2 * q + 1]); o1[q] = pack2(v[8 + 2 * q], v[8 + 2 * q + 1]); }
                *(u32x4*)(Kp + hb + key * 64 + d0) = o0;
                *(u32x4*)(Kp + hb + key * 64 + d0 + 8) = o1;
            } else {
                bf16_t* vt = Vtp + hb + (size_t)d0 * 256 + key;
#pragma unroll
                for (int e = 0; e < 16; ++e) vt[e * 256] = f2bf(v[e]);
            }
        }
    }
}
__device__ __forceinline__ void gate_tile(int t, const bf16_t* xb, const bf16_t* Wg, bf16_t* G, bf16_t* sm) {
    const int tid_ = tidx();
    const int lane = tid_ & 63, wid = tid_ >> 6, wr = wid >> 1, wc = wid & 1, fr = lane & 15, fq = lane >> 4;
    const int tm = t >> 5, tn = t & 31;
    f32x4 acc[4][4]; zero_acc<4>(acc);
    gemm_tile<4>(acc, xb + (size_t)tm * 128 * 1024, 1024, Wg + (size_t)tn * 128 * 1024, 1024, 1024, sm);
#pragma unroll
    for (int mt = 0; mt < 4; ++mt) {
        const int row = tm * 128 + wr * 64 + mt * 16 + fr;
        const int cbase = tn * 128 + wc * 64 + fq * 16;
        float v[16]; gather_cols<4>(acc, mt, v);
        u32x4 o0, o1;
#pragma unroll
        for (int q = 0; q < 4; ++q) {
            o0[q] = pack2(sigmoid_(v[2 * q]), sigmoid_(v[2 * q + 1]));
            o1[q] = pack2(sigmoid_(v[8 + 2 * q]), sigmoid_(v[8 + 2 * q + 1]));
        }
        *(u32x4*)(G + (size_t)row * 4096 + cbase) = o0;
        *(u32x4*)(G + (size_t)row * 4096 + cbase + 8) = o1;
    }
}
__device__ __forceinline__ void phase_merge(const bf16_t* G, const bf16_t* BO, const bf16_t* Wb, bf16_t* M, bf16_t* sm) {
    const int tid_ = tidx();
    const int lane = tid_ & 63, wid = tid_ >> 6, wr = wid >> 1, wc = wid & 1, fr = lane & 15, fq = lane >> 4;
    for (int t = blockIdx.x; t < 136 * 16; t += gridDim.x) {
        const int tm = t >> 4, tn = t & 15;
        const int cbase = tn * 64 + wc * 32 + fq * 8;
        f32x4 accm[4][2]; zero_acc<2>(accm);
#pragma unroll 1
        for (int i = 0; i < 4; ++i) {
            f32x4 accb[4][2]; zero_acc<2>(accb);
            const int koff = i * 512, kk = i < 3 ? 512 : 256;
            gemm_tile<2>(accb, BO + (size_t)tm * 128 * 1792 + koff, 1792, Wb + (size_t)tn * 64 * 1792 + koff, 1792, kk, sm);
#pragma unroll
            for (int mt = 0; mt < 4; ++mt) {
                const int row = tm * 128 + wr * 64 + mt * 16 + fr;
                const u32x4 gu = *(const u32x4*)(G + (size_t)row * 4096 + i * 1024 + cbase);
#pragma unroll
                for (int e = 0; e < 8; ++e) {
                    const float gv = (e & 1) ? hi2f(gu[e >> 1]) : lo2f(gu[e >> 1]);
                    accm[mt][e % 2][e / 2] += gv * accb[mt][e % 2][e / 2];
                }
            }
        }
#pragma unroll
        for (int mt = 0; mt < 4; ++mt) {
            const int row = tm * 128 + wr * 64 + mt * 16 + fr;
            float v[8]; gather_cols<2>(accm, mt, v);
            u32x4 o;
#pragma unroll
            for (int q = 0; q < 4; ++q) o[q] = pack2(v[2 * q], v[2 * q + 1]);
            *(u32x4*)(M + (size_t)row * 1024 + cbase) = o;
        }
    }
}
__device__ __forceinline__ void pool_gemm_tile(int t, const bf16_t* pooled, const bf16_t* PoolT, const float* pscale, bf16_t* BO, bf16_t* sm) {
    const int tid_ = tidx();
    const int lane = tid_ & 63, wid = tid_ >> 6, wr = wid >> 1, wc = wid & 1, fr = lane & 15, fq = lane >> 4;
    const int tm = t >> 2, g = t & 3;
    f32x4 acc[4][4]; zero_acc<4>(acc);
    gemm_tile<4>(acc, pooled + (size_t)tm * 128 * 512 + g * 128, 512, PoolT + g * 16384, 128, 128, sm);
    const int cbase = g * 128 + wc * 64 + fq * 16;
    float ps[16];
#pragma unroll
    for (int q = 0; q < 4; ++q) { const float4 s4 = *(const float4*)(pscale + cbase + 4 * q); ps[4 * q] = s4.x; ps[4 * q + 1] = s4.y; ps[4 * q + 2] = s4.z; ps[4 * q + 3] = s4.w; }
#pragma unroll
    for (int mt = 0; mt < 4; ++mt) {
        const int row = tm * 128 + wr * 64 + mt * 16 + fr;
        float v[16]; gather_cols<4>(acc, mt, v);
        u32x4 o0, o1;
#pragma unroll
        for (int q = 0; q < 4; ++q) {
            o0[q] = pack2(v[2 * q] * ps[2 * q], v[2 * q + 1] * ps[2 * q + 1]);
            o1[q] = pack2(v[8 + 2 * q] * ps[8 + 2 * q], v[8 + 2 * q + 1] * ps[8 + 2 * q + 1]);
        }
        *(u32x4*)(BO + (size_t)row * 1792 + 512 + cbase) = o0;
        *(u32x4*)(BO + (size_t)row * 1792 + 512 + cbase + 8) = o1;
    }
}

__device__ __forceinline__ void phase_ln(const float* Y, float* X, bf16_t* xb, const float* g, const float* b) {
    const int tid_ = tidx();
    const int lane = tid_ & 63, wid = tid_ >> 6;
    const int stride = gridDim.x * 4;
    int row = blockIdx.x * 4 + wid;
    float4 v[4], vn[4];
    if (row < NTOK) {
#pragma unroll
        for (int i = 0; i < 4; ++i) v[i] = ((const float4*)(Y + (size_t)row * 1024))[lane + 64 * i];
    }
    float4 gg[4], bb[4];
#pragma unroll
    for (int i = 0; i < 4; ++i) { gg[i] = ((const float4*)g)[lane + 64 * i]; bb[i] = ((const float4*)b)[lane + 64 * i]; }
    for (; row < NTOK; row += stride) {
        const int nrow = row + stride;
        if (nrow < NTOK) {
#pragma unroll
            for (int i = 0; i < 4; ++i) vn[i] = ((const float4*)(Y + (size_t)nrow * 1024))[lane + 64 * i];
        }
        float s = 0.f;
#pragma unroll
        for (int i = 0; i < 4; ++i) s += v[i].x + v[i].y + v[i].z + v[i].w;
        const float mean = wave_sum(s) * (1.f / 1024.f);
        float q = 0.f;
#pragma unroll
        for (int i = 0; i < 4; ++i) {
            v[i].x -= mean; v[i].y -= mean; v[i].z -= mean; v[i].w -= mean;
            q += v[i].x * v[i].x + v[i].y * v[i].y + v[i].z * v[i].z + v[i].w * v[i].w;
        }
        const float rstd = rsqrtf(wave_sum(q) * (1.f / 1024.f) + 1e-5f);
#pragma unroll
        for (int i = 0; i < 4; ++i) {
            const int c4 = lane + 64 * i;
            float4 o;
            o.x = v[i].x * rstd * gg[i].x + bb[i].x; o.y = v[i].y * rstd * gg[i].y + bb[i].y;
            o.z = v[i].z * rstd * gg[i].z + bb[i].z; o.w = v[i].w * rstd * gg[i].w + bb[i].w;
            ((float4*)(X + (size_t)row * 1024))[c4] = o;
            ((uint2*)(xb + (size_t)row * 1024))[c4] = make_uint2(pack2(o.x, o.y), pack2(o.z, o.w));
        }
#pragma unroll
        for (int i = 0; i < 4; ++i) v[i] = vn[i];
    }
}

__device__ __forceinline__ void conv_sample_kv(KP p, int l) {
    const int tid_ = tidx();
    const size_t gt = (size_t)blockIdx.x * 256 + tid_, gs = (size_t)gridDim.x * 256;
    const float* ck = p->in[I_CMK] + (size_t)l * 128 * 256 * 256;
    const float* cv = p->in[I_CMV] + (size_t)l * 128 * 256 * 256;
    bf16_t* Ks = (bf16_t*)(p->ws + OFF_KS); bf16_t* Vts = (bf16_t*)(p->ws + OFF_VTS);
    for (size_t i0 = gt; i0 < (size_t)128 * 256 * 64; i0 += 4 * gs) {
        float4 v[4];
#pragma unroll
        for (int u = 0; u < 4; ++u) { const size_t i = i0 + u * gs; if (i < (size_t)128 * 256 * 64) v[u] = ((const float4*)ck)[i]; }
#pragma unroll
        for (int u = 0; u < 4; ++u) {
            const size_t i = i0 + u * gs;
            if (i < (size_t)128 * 256 * 64) {
                const int d4 = i & 15, h = (i >> 4) & 3, key = (i >> 6) & 255, b = (int)(i >> 14);
                *(uint2*)(Ks + ((size_t)(b * 4 + h) * 256 + key) * 64 + d4 * 4) = make_uint2(pack2(v[u].x, v[u].y), pack2(v[u].z, v[u].w));
            }
        }
    }
    for (size_t i0 = gt; i0 < (size_t)128 * 64 * 256; i0 += 4 * gs) {
        float v[4][4];
#pragma unroll
        for (int u = 0; u < 4; ++u) {
            const size_t i = i0 + u * gs;
            if (i < (size_t)128 * 64 * 256) {
                const int d = i & 63, h = (i >> 6) & 3, kq = (i >> 8) & 63, b = (int)(i >> 14);
#pragma unroll
                for (int j = 0; j < 4; ++j) v[u][j] = cv[((size_t)(b * 256 + kq * 4 + j) * 4 + h) * 64 + d];
            }
        }
#pragma unroll
        for (int u = 0; u < 4; ++u) {
            const size_t i = i0 + u * gs;
            if (i < (size_t)128 * 64 * 256) {
                const int d = i & 63, h = (i >> 6) & 3, kq = (i >> 8) & 63, b = (int)(i >> 14);
                *(uint2*)(Vts + ((size_t)(b * 4 + h) * 64 + d) * 256 + kq * 4) = make_uint2(pack2(v[u][0], v[u][1]), pack2(v[u][2], v[u][3]));
            }
        }
    }
}

__device__ __forceinline__ void attn_task(const bf16_t* P, int rowbase, int nvalid, const bf16_t* Kb, const bf16_t* Vt, bf16_t* BO, int h) {
    const int tid_ = tidx();
    const int lane = tid_ & 63, fr = lane & 15, fq = lane >> 4;
    const int qrow = rowbase + (fr < nvalid ? fr : nvalid - 1);
    const bf16_t* qp = P + (size_t)qrow * PW + PM + h * 64 + fq * 8;
    const bf16x8 qb0 = *(const bf16x8*)qp, qb1 = *(const bf16x8*)(qp + 32);
    f32x4 s[16];
#pragma unroll
    for (int mt = 0; mt < 16; ++mt) {
        const bf16_t* kp = Kb + (mt * 16 + fr) * 64 + fq * 8;
        const bf16x8 a0 = *(const bf16x8*)kp, a1 = *(const bf16x8*)(kp + 32);
        f32x4 z = {0.f, 0.f, 0.f, 0.f};
        z = __builtin_amdgcn_mfma_f32_16x16x32_bf16(a0, qb0, z, 0, 0, 0);
        s[mt] = __builtin_amdgcn_mfma_f32_16x16x32_bf16(a1, qb1, z, 0, 0, 0);
    }
    float mx = -3.0e38f;
#pragma unroll
    for (int mt = 0; mt < 16; ++mt)
#pragma unroll
        for (int j = 0; j < 4; ++j) { s[mt][j] *= 0.125f; mx = fmaxf(mx, s[mt][j]); }
    mx = fmaxf(mx, __shfl_xor(mx, 16)); mx = fmaxf(mx, __shfl_xor(mx, 32));
    float sum = 0.f;
#pragma unroll
    for (int mt = 0; mt < 16; ++mt)
#pragma unroll
        for (int j = 0; j < 4; ++j) { const float e = __expf(s[mt][j] - mx); s[mt][j] = e; sum += e; }
    sum += __shfl_xor(sum, 16); sum += __shfl_xor(sum, 32);
    f32x4 o[4];
#pragma unroll
    for (int dt = 0; dt < 4; ++dt) o[dt] = (f32x4){0.f, 0.f, 0.f, 0.f};
#pragma unroll
    for (int st = 0; st < 8; ++st) {
        union { bf16x8 v; unsigned u[4]; } pb;
        pb.u[0] = pack2(s[2 * st][0], s[2 * st][1]); pb.u[1] = pack2(s[2 * st][2], s[2 * st][3]);
        pb.u[2] = pack2(s[2 * st + 1][0], s[2 * st + 1][1]); pb.u[3] = pack2(s[2 * st + 1][2], s[2 * st + 1][3]);
#pragma unroll
        for (int dt = 0; dt < 4; ++dt) {
            const bf16_t* vp = Vt + (dt * 16 + fr) * 256 + st * 32 + fq * 4;
            union { bf16x8 v; uint2 u[2]; } av;
            av.u[0] = *(const uint2*)vp; av.u[1] = *(const uint2*)(vp + 16);
            o[dt] = __builtin_amdgcn_mfma_f32_16x16x32_bf16(av.v, pb.v, o[dt], 0, 0, 0);
        }
    }
    const float inv = 1.f / sum;
    if (fr < nvalid) {
#pragma unroll
        for (int dt = 0; dt < 4; ++dt)
            *(uint2*)(BO + (size_t)(rowbase + fr) * 1792 + 1536 + h * 64 + dt * 16 + fq * 4) =
                make_uint2(pack2(o[dt][0] * inv, o[dt][1] * inv), pack2(o[dt][2] * inv, o[dt][3] * inv));
    }
}

__device__ __forceinline__ void rwkv_prep_task(KP p, int l, int tile, int hg, bf16_t* sAp) {
    const int tid_ = tidx();
    const int tid = tid_, lane = tid & 63, wid = tid >> 6, fr = lane & 15, fq = lane >> 4;
    const bf16_t* P = (const bf16_t*)(p->ws + OFF_P);
    const float* mu = p->in[I_MU] + l * 1792;
    const float* shs = p->in[I_SSHIFT] + (size_t)l * 128 * 1792;
    const int row0 = tile * 16;
    const bool samp = row0 >= TPROMPT;
    const int sb0 = samp ? (row0 - TPROMPT) >> 3 : 0;
    {
        const int c = tid, col = 1536 + c;
        const float m = mu[col];
        float cur[17];
#pragma unroll
        for (int i = 0; i < 17; ++i) cur[i] = bf2f(P[(size_t)(row0 + i > 0 ? row0 + i - 1 : 0) * PW + col]);
        const float sh0 = shs[(size_t)sb0 * 1792 + col], sh1 = shs[(size_t)(sb0 + 1 < 128 ? sb0 + 1 : 127) * 1792 + col];
#pragma unroll
        for (int i = 0; i < 16; ++i) {
            float pv = cur[i];
            if (!samp) { if (((row0 + i) & 2047) == 0) pv = 0.f; }
            else { if (i == 0) pv = sh0; if (i == 8) pv = sh1; }
            const float xm = cur[i + 1] + (pv - cur[i + 1]) * m;
            const float val = c < 64 ? tanh_(xm) : (c < 128 ? xm : sigmoid_(xm));
            sAp[i * 264 + c] = f2bf(val);
        }
    }
    __syncthreads();
    const int h = hg * 4 + wid;
    bf16x8 af[8];
#pragma unroll
    for (int ks = 0; ks < 8; ++ks) af[ks] = *(const bf16x8*)(sAp + fr * 264 + ks * 32 + fq * 8);
    const bf16_t* WupT = (const bf16_t*)(p->ws + OFF_WUP);
    const bf16_t* AupT = (const bf16_t*)(p->ws + OFF_AUP);
    const bf16_t* GupT = (const bf16_t*)(p->ws + OFF_GUP);
    f32x4 az[4], aa[4], ag[4];
#pragma unroll
    for (int nt = 0; nt < 4; ++nt) {
        const int n = h * 64 + fr * 4 + nt;
        f32x4 z = {0.f, 0.f, 0.f, 0.f};
        z = __builtin_amdgcn_mfma_f32_16x16x32_bf16(*(const bf16x8*)(WupT + n * 64 + fq * 8), af[0], z, 0, 0, 0);
        z = __builtin_amdgcn_mfma_f32_16x16x32_bf16(*(const bf16x8*)(WupT + n * 64 + 32 + fq * 8), af[1], z, 0, 0, 0);
        az[nt] = z;
        f32x4 a = {0.f, 0.f, 0.f, 0.f};
        a = __builtin_amdgcn_mfma_f32_16x16x32_bf16(*(const bf16x8*)(AupT + n * 64 + fq * 8), af[2], a, 0, 0, 0);
        a = __builtin_amdgcn_mfma_f32_16x16x32_bf16(*(const bf16x8*)(AupT + n * 64 + 32 + fq * 8), af[3], a, 0, 0, 0);
        aa[nt] = a;
        f32x4 g = {0.f, 0.f, 0.f, 0.f};
#pragma unroll
        for (int ks = 0; ks < 4; ++ks)
            g = __builtin_amdgcn_mfma_f32_16x16x32_bf16(*(const bf16x8*)(GupT + n * 128 + ks * 32 + fq * 8), af[4 + ks], g, 0, 0, 0);
        ag[nt] = g;
    }
    float* Rw = (float*)(p->ws + OFF_RW);
    bf16_t* Rkk = (bf16_t*)(p->ws + OFF_RKK); bf16_t* Rka = (bf16_t*)(p->ws + OFF_RKA); bf16_t* Rkp = (bf16_t*)(p->ws + OFF_RKP);
    bf16_t* Rr = (bf16_t*)(p->ws + OFF_RR); bf16_t* Rv = (bf16_t*)(p->ws + OFF_RV); bf16_t* Rg = (bf16_t*)(p->ws + OFF_RG);
    float* Rc = (float*)(p->ws + OFF_RC);
    const int R = row0 + fr;
    bool first; int sb = 0;
    if (!samp) first = (R & 2047) == 0; else { const int rs = R - TPROMPT; first = (rs & 7) == 0; sb = rs >> 3; }
    const int cb = h * 64 + fq * 16;
    float x3[3][16];
#pragma unroll
    for (int q = 0; q < 3; ++q) {
        const int col = q * 512 + cb;
        const u32x4 c0 = *(const u32x4*)(P + (size_t)R * PW + col), c1 = *(const u32x4*)(P + (size_t)R * PW + col + 8);
        const u32x4 p0 = *(const u32x4*)(P + (size_t)(R > 0 ? R - 1 : 0) * PW + col), p1 = *(const u32x4*)(P + (size_t)(R > 0 ? R - 1 : 0) * PW + col + 8);
#pragma unroll
        for (int e4 = 0; e4 < 4; ++e4) {
            const float4 su = *(const float4*)(shs + (size_t)sb * 1792 + col + e4 * 4);
            const float4 m4 = *(const float4*)(mu + col + e4 * 4);
            const float sv[4] = {su.x, su.y, su.z, su.w}, mm[4] = {m4.x, m4.y, m4.z, m4.w};
#pragma unroll
            for (int k = 0; k < 4; ++k) {
                const int e = e4 * 4 + k;
                const unsigned cu = e < 8 ? c0[e >> 1] : c1[(e - 8) >> 1], pu = e < 8 ? p0[e >> 1] : p1[(e - 8) >> 1];
                const float cv = (e & 1) ? hi2f(cu) : lo2f(cu), pp = (e & 1) ? hi2f(pu) : lo2f(pu);
                const float prev = first ? (samp ? sv[k] : 0.f) : pp;
                x3[q][e] = cv + (prev - cv) * mm[k];
            }
        }
    }
    float kkv[16], av[16];
    float ss = 0.f, bon = 0.f;
    const size_t o = (size_t)R * 512 + cb;
#pragma unroll
    for (int e4 = 0; e4 < 4; ++e4) {
        const float4 w04 = *(const float4*)(p->in[I_W0] + l * 512 + cb + e4 * 4), a04 = *(const float4*)(p->in[I_A0] + l * 512 + cb + e4 * 4);
        const float4 kk4 = *(const float4*)(p->in[I_KK] + l * 512 + cb + e4 * 4), ka4 = *(const float4*)(p->in[I_KA] + l * 512 + cb + e4 * 4);
        const float4 rk4 = *(const float4*)(p->in[I_RK] + l * 512 + cb + e4 * 4);
        const float w0v[4] = {w04.x, w04.y, w04.z, w04.w}, a0v[4] = {a04.x, a04.y, a04.z, a04.w};
        const float kkp[4] = {kk4.x, kk4.y, kk4.z, kk4.w}, kap[4] = {ka4.x, ka4.y, ka4.z, ka4.w}, rkp[4] = {rk4.x, rk4.y, rk4.z, rk4.w};
        float wd[4], kp[4];
#pragma unroll
        for (int k = 0; k < 4; ++k) {
            const int e = e4 * 4 + k;
            const float z = w0v[k] + az[k][e4];
            wd[k] = __expf(-__expf(-softplus_(-z) - 0.5f));
            const float a = sigmoid_(a0v[k] + aa[k][e4]);
            const float kx = x3[1][e];
            kkv[e] = kx * kkp[k];
            kp[k] = kx * (1.f + (a - 1.f) * kap[k]);
            av[e] = a;
            ss += kkv[e] * kkv[e];
            bon += x3[0][e] * kp[k] * rkp[k];
        }
        *(float4*)(Rw + o + e4 * 4) = make_float4(wd[0], wd[1], wd[2], wd[3]);
        *(uint2*)(Rkp + o + e4 * 4) = make_uint2(pack2(kp[0], kp[1]), pack2(kp[2], kp[3]));
        *(uint2*)(Rr + o + e4 * 4) = make_uint2(pack2(x3[0][e4 * 4], x3[0][e4 * 4 + 1]), pack2(x3[0][e4 * 4 + 2], x3[0][e4 * 4 + 3]));
        *(uint2*)(Rv + o + e4 * 4) = make_uint2(pack2(x3[2][e4 * 4], x3[2][e4 * 4 + 1]), pack2(x3[2][e4 * 4 + 2], x3[2][e4 * 4 + 3]));
        *(uint2*)(Rg + o + e4 * 4) = make_uint2(pack2(ag[0][e4], ag[1][e4]), pack2(ag[2][e4], ag[3][e4]));
    }
    ss += __shfl_xor(ss, 16); ss += __shfl_xor(ss, 32);
    bon += __shfl_xor(bon, 16); bon += __shfl_xor(bon, 32);
    const float inv = rsqrtf(ss + 1e-12f);
#pragma unroll
    for (int hf = 0; hf < 2; ++hf) {
        u32x4 vkk, vka;
#pragma unroll
        for (int k = 0; k < 4; ++k) {
            const int e = hf * 8 + k * 2;
            const float k0 = kkv[e] * inv, k1 = kkv[e + 1] * inv;
            vkk[k] = pack2(k0, k1); vka[k] = pack2(k0 * av[e], k1 * av[e + 1]);
        }
        *(u32x4*)(Rkk + o + hf * 8) = vkk; *(u32x4*)(Rka + o + hf * 8) = vka;
    }
    if (fq == 0) Rc[(size_t)R * 8 + h] = bon;
    __syncthreads();
}

__device__ __forceinline__ void delta_prep_row(KP p, int l, int R) {
    const int tid_ = tidx();
    const int lane = tid_ & 63;
    const bf16_t* P = (const bf16_t*)(p->ws + OFF_P);
    bf16_t* Dq = (bf16_t*)(p->ws + OFF_DQ); bf16_t* Dk = (bf16_t*)(p->ws + OFF_DK); bf16_t* Dv = (bf16_t*)(p->ws + OFF_DV);
    float* Dsc = (float*)(p->ws + OFF_DSC);
    int t, seq0, sb = 0; bool samp = R >= TPROMPT;
    if (!samp) { t = R & 2047; seq0 = R - t; } else { const int rs = R - TPROMPT; t = rs & 7; sb = rs >> 3; seq0 = R - t; }
    const float* cbuf = p->in[I_SCONV] + (size_t)(l * 128 + sb) * 3 * 1536;
    const float* cw = p->in[I_CONVW] + (size_t)l * 4 * 1536;
    const bool edge = samp || t < 3;
#pragma unroll 1
    for (int sg = 0; sg < 3; ++sg) {
        float va[4][2];
        if (!edge) {
#pragma unroll
            for (int s4 = 0; s4 < 4; ++s4) {
                const int c = (sg * 4 + s4) * 128 + lane * 2;
                unsigned u[4]; float2 w[4];
#pragma unroll
                for (int j = 0; j < 4; ++j) {
                    u[j] = *(const unsigned*)(P + (size_t)(R - 3 + j) * PW + PC + c);
                    w[j] = *(const float2*)(cw + (size_t)j * 1536 + c);
                }
                float a0 = 0.f, a1 = 0.f;
#pragma unroll
                for (int j = 0; j < 4; ++j) { a0 += lo2f(u[j]) * w[j].x; a1 += hi2f(u[j]) * w[j].y; }
                va[s4][0] = silu_(a0); va[s4][1] = silu_(a1);
            }
        } else {
#pragma unroll
            for (int s4 = 0; s4 < 4; ++s4) {
                const int c = (sg * 4 + s4) * 128 + lane * 2;
                unsigned u[4]; float2 w[4], f[4];
#pragma unroll
                for (int j = 0; j < 4; ++j) {
                    const int tau = t - 3 + j;
                    u[j] = *(const unsigned*)(P + (size_t)(seq0 + (tau >= 0 ? tau : 0)) * PW + PC + c);
                    int bi = 3 + tau; bi = bi < 0 ? 0 : (bi > 2 ? 2 : bi);
                    f[j] = *(const float2*)(cbuf + (size_t)bi * 1536 + c);
                    w[j] = *(const float2*)(cw + (size_t)j * 1536 + c);
                }
                float a0 = 0.f, a1 = 0.f;
#pragma unroll
                for (int j = 0; j < 4; ++j) {
                    const int tau = t - 3 + j;
                    const float x0 = tau >= 0 ? lo2f(u[j]) : (samp ? f[j].x : 0.f);
                    const float x1 = tau >= 0 ? hi2f(u[j]) : (samp ? f[j].y : 0.f);
                    a0 += x0 * w[j].x; a1 += x1 * w[j].y;
                }
                va[s4][0] = silu_(a0); va[s4][1] = silu_(a1);
            }
        }
        bf16_t* dst = sg == 0 ? Dq : (sg == 1 ? Dk : Dv);
#pragma unroll
        for (int s4 = 0; s4 < 4; ++s4) {
            float a0 = va[s4][0], a1 = va[s4][1];
            if (sg < 2) {
                const float ss = wave_sum(a0 * a0 + a1 * a1);
                float sc = rsqrtf(ss + 1e-12f);
                if (sg == 0) sc *= 0.08838834764831845f;
                a0 *= sc; a1 *= sc;
            }
            *(unsigned*)(dst + (size_t)R * 512 + s4 * 128 + lane * 2) = pack2(a0, a1);
        }
    }
    {
        bf16_t* SZ = (bf16_t*)(p->ws + OFF_SZ);
        unsigned zu[4];
#pragma unroll
        for (int hh = 0; hh < 4; ++hh) zu[hh] = *(const unsigned*)(P + (size_t)R * PW + PC + 1536 + hh * 128 + lane * 2);
#pragma unroll
        for (int hh = 0; hh < 4; ++hh) *(unsigned*)(SZ + (size_t)R * 512 + hh * 128 + lane * 2) = pack2(silu_(lo2f(zu[hh])), silu_(hi2f(zu[hh])));
    }
    if (lane < 4) {
        const float bb = bf2f(P[(size_t)R * PW + PBA + lane]);
        const float aa = bf2f(P[(size_t)R * PW + PBA + 4 + lane]);
        const float beta = sigmoid_(bb);
        const float g = -__expf(p->in[I_ALOG][l * 4 + lane]) * softplus_(aa + p->in[I_DTB][l * 4 + lane]);
        Dsc[((size_t)R * 4 + lane) * 2] = beta;
        Dsc[((size_t)R * 4 + lane) * 2 + 1] = __expf(g);
    }
}

__device__ __forceinline__ void delta_prep_quad(KP p, int l, int R0) {
    const int tid_ = tidx();
    const int lane = tid_ & 63;
    const bf16_t* P = (const bf16_t*)(p->ws + OFF_P);
    bf16_t* Dq = (bf16_t*)(p->ws + OFF_DQ); bf16_t* Dk = (bf16_t*)(p->ws + OFF_DK); bf16_t* Dv = (bf16_t*)(p->ws + OFF_DV);
    float* Dsc = (float*)(p->ws + OFF_DSC);
    bf16_t* SZ = (bf16_t*)(p->ws + OFF_SZ);
    const float* cw = p->in[I_CONVW] + (size_t)l * 4 * 1536;
#pragma unroll 1
    for (int sg = 0; sg < 3; ++sg) {
        unsigned u[4][7]; float2 w[4][4];
#pragma unroll
        for (int s4 = 0; s4 < 4; ++s4) {
            const int c = (sg * 4 + s4) * 128 + lane * 2;
#pragma unroll
            for (int r = 0; r < 7; ++r) u[s4][r] = *(const unsigned*)(P + (size_t)(R0 - 3 + r) * PW + PC + c);
#pragma unroll
            for (int j = 0; j < 4; ++j) w[s4][j] = *(const float2*)(cw + (size_t)j * 1536 + c);
        }
        float v0[4][4], v1[4][4];
#pragma unroll
        for (int tk = 0; tk < 4; ++tk)
#pragma unroll
            for (int s4 = 0; s4 < 4; ++s4) {
                float a0 = 0.f, a1 = 0.f;
#pragma unroll
                for (int j = 0; j < 4; ++j) { a0 += lo2f(u[s4][tk + j]) * w[s4][j].x; a1 += hi2f(u[s4][tk + j]) * w[s4][j].y; }
                v0[tk][s4] = silu_(a0); v1[tk][s4] = silu_(a1);
            }
        if (sg < 2) {
            float ss[4][4];
#pragma unroll
            for (int tk = 0; tk < 4; ++tk)
#pragma unroll
                for (int s4 = 0; s4 < 4; ++s4) ss[tk][s4] = red16(v0[tk][s4] * v0[tk][s4] + v1[tk][s4] * v1[tk][s4]);
#pragma unroll
            for (int tk = 0; tk < 4; ++tk)
#pragma unroll
                for (int s4 = 0; s4 < 4; ++s4) { float t = ss[tk][s4]; t += __shfl_xor(t, 16); ss[tk][s4] = t; }
#pragma unroll
            for (int tk = 0; tk < 4; ++tk)
#pragma unroll
                for (int s4 = 0; s4 < 4; ++s4) {
                    float t = ss[tk][s4]; t += __shfl_xor(t, 32);
                    float sc = rsqrtf(t + 1e-12f);
                    if (sg == 0) sc *= 0.08838834764831845f;
                    v0[tk][s4] *= sc; v1[tk][s4] *= sc;
                }
        }
        bf16_t* dst = sg == 0 ? Dq : (sg == 1 ? Dk : Dv);
#pragma unroll
        for (int tk = 0; tk < 4; ++tk)
#pragma unroll
            for (int s4 = 0; s4 < 4; ++s4)
                *(unsigned*)(dst + (size_t)(R0 + tk) * 512 + s4 * 128 + lane * 2) = pack2(v0[tk][s4], v1[tk][s4]);
    }
    {
        unsigned zu[4][4];
#pragma unroll
        for (int tk = 0; tk < 4; ++tk)
#pragma unroll
            for (int hh = 0; hh < 4; ++hh) zu[tk][hh] = *(const unsigned*)(P + (size_t)(R0 + tk) * PW + PC + 1536 + hh * 128 + lane * 2);
#pragma unroll
        for (int tk = 0; tk < 4; ++tk)
#pragma unroll
            for (int hh = 0; hh < 4; ++hh)
                *(unsigned*)(SZ + (size_t)(R0 + tk) * 512 + hh * 128 + lane * 2) = pack2(silu_(lo2f(zu[tk][hh])), silu_(hi2f(zu[tk][hh])));
    }
    if (lane < 16) {
        const int R = R0 + (lane >> 2), hh = lane & 3;
        const float bb = bf2f(P[(size_t)R * PW + PBA + hh]);
        const float aa = bf2f(P[(size_t)R * PW + PBA + 4 + hh]);
        const float g = -__expf(p->in[I_ALOG][l * 4 + hh]) * softplus_(aa + p->in[I_DTB][l * 4 + hh]);
        Dsc[((size_t)R * 4 + hh) * 2] = sigmoid_(bb);
        Dsc[((size_t)R * 4 + hh) * 2 + 1] = __expf(g);
    }
}

template <int W, bool EDGE>
__device__ __forceinline__ void pooled_item(const bf16_t* P, const float* pbuf, bf16_t* pooled, int R, int c, int t, int seq0, bool samp) {
    unsigned u[W]; float2 f[W];
#pragma unroll
    for (int q = 0; q < W; ++q) {
        const int tau = t - q;
        if (EDGE) {
            u[q] = *(const unsigned*)(P + (size_t)(seq0 + (tau >= 0 ? tau : 0)) * PW + PB + c);
            int bi = 15 + tau; bi = bi < 0 ? 0 : (bi > 14 ? 14 : bi);
            f[q] = *(const float2*)(pbuf + (size_t)bi * 512 + c);
        } else {
            u[q] = *(const unsigned*)(P + (size_t)(R - q) * PW + PB + c);
        }
    }
    float s0 = 0.f, s1 = 0.f;
#pragma unroll
    for (int q = 0; q < W; ++q) {
        const int tau = t - q;
        float x0 = lo2f(u[q]), x1 = hi2f(u[q]);
        if (EDGE) { if (tau < 0) { x0 = samp ? f[q].x : 0.f; x1 = samp ? f[q].y : 0.f; } }
        s0 += x0; s1 += x1;
    }
    const float cnt = samp ? (float)W : (float)(t + 1 < W ? t + 1 : W);
    *(unsigned*)(pooled + (size_t)R * 512 + c) = pack2(s0 / cnt - lo2f(u[0]), s1 / cnt - hi2f(u[0]));
}

template <int W>
__device__ __forceinline__ void pooled_blk16(const bf16_t* P, bf16_t* pooled, int R0, int c) {
    const int t0 = R0 & 2047;
    float x0[31], x1[31];
#pragma unroll
    for (int i = 0; i < 31; ++i) {
        x0[i] = 0.f; x1[i] = 0.f;
        if (i >= 16 - W) {
            const int tt = t0 - 15 + i;
            const unsigned v = *(const unsigned*)(P + (size_t)(tt >= 0 ? R0 - 15 + i : R0) * PW + PB + c);
            x0[i] = tt >= 0 ? lo2f(v) : 0.f; x1[i] = tt >= 0 ? hi2f(v) : 0.f;
        }
    }
#pragma unroll
    for (int i = 0; i < 16; ++i) {
        float s0 = 0.f, s1 = 0.f;
#pragma unroll
        for (int q = 0; q < W; ++q) { s0 += x0[15 + i - q]; s1 += x1[15 + i - q]; }
        const int t = t0 + i;
        const float inv = 1.f / (float)(t + 1 < W ? t + 1 : W);
        *(unsigned*)(pooled + (size_t)(R0 + i) * 512 + c) = pack2(s0 * inv - x0[15 + i], s1 * inv - x1[15 + i]);
    }
}

__device__ __forceinline__ void attn_block_task(KP p, int l, int k) {
    const int tid_ = tidx();
    const int wid = tid_ >> 6;
    const bf16_t* P = (const bf16_t*)(p->ws + OFF_P);
    bf16_t* BO = (bf16_t*)(p->ws + OFF_BO);
    const int t = k * 4 + wid;
    if (t < 4096 + 512) {
            int rowbase, nvalid, h; const bf16_t* kb; const bf16_t* vt;
            if (t < 4096) {
                const int qt = t & 127, b = t >> 9; h = (t >> 7) & 3;
                const size_t kvo = ((size_t)((l * 8 + b) * 4 + h)) * 16384;
                rowbase = b * 2048 + qt * 16; nvalid = 16;
                kb = (const bf16_t*)(p->ws + OFF_KP) + kvo; vt = (const bf16_t*)(p->ws + OFF_VTP) + kvo;
            } else {
                const int u = t - 4096, b = u >> 2; h = u & 3;
                const size_t kvo = ((size_t)(b * 4 + h)) * 16384;
                rowbase = TPROMPT + b * 8; nvalid = 8;
                kb = (const bf16_t*)(p->ws + OFF_KS) + kvo; vt = (const bf16_t*)(p->ws + OFF_VTS) + kvo;
            }
            attn_task(P, rowbase, nvalid, kb, vt, BO, h);
    }
}
__device__ __forceinline__ void misc_vblock(KP p, int l, int vb, int nvb) {
    const int tid_ = tidx();
    const int tid = tid_;
    const bf16_t* P = (const bf16_t*)(p->ws + OFF_P);
    const size_t gt = (size_t)vb * 256 + tid, gs = (size_t)nvb * 256;
    {
        bf16_t* pooled = (bf16_t*)(p->ws + OFF_POOLED);
        for (size_t i = gt; i < (size_t)(TPROMPT / 16) * 256; i += gs) {
            const int R0 = (int)(i >> 8) * 16, c = (int)(i & 255) * 2, w = 2 << (c >> 7);
            if (w == 2) pooled_blk16<2>(P, pooled, R0, c);
            else if (w == 4) pooled_blk16<4>(P, pooled, R0, c);
            else if (w == 8) pooled_blk16<8>(P, pooled, R0, c);
            else pooled_blk16<16>(P, pooled, R0, c);
        }
        for (size_t i = gt; i < (size_t)(NTOK - TPROMPT) * 256; i += gs) {
            const int R = TPROMPT + (int)(i >> 8), c = (int)(i & 255) * 2, w = 2 << (c >> 7);
            const int rs = R - TPROMPT, t = rs & 7, sb = rs >> 3, seq0 = R - t;
            const float* pbuf = p->in[I_SPOOL] + (size_t)(l * 128 + sb) * 15 * 512;
            if (w == 2) pooled_item<2, true>(P, pbuf, pooled, R, c, t, seq0, true);
            else if (w == 4) pooled_item<4, true>(P, pbuf, pooled, R, c, t, seq0, true);
            else if (w == 8) pooled_item<8, true>(P, pbuf, pooled, R, c, t, seq0, true);
            else pooled_item<16, true>(P, pbuf, pooled, R, c, t, seq0, true);
        }
    }
    {
        float* out = p->out;
        for (size_t i = gt; i < (size_t)136 * 448; i += gs) {
            const int sq = (int)(i / 448), c = (int)(i % 448) * 4;
            const int row = sq < 8 ? sq * 2048 + 2047 : TPROMPT + (sq - 8) * 8 + 7;
            const uint2 u = *(const uint2*)(P + (size_t)row * PW + c);
            float* dst = sq < 8 ? out + O_PSHIFT + (size_t)(l * 8 + sq) * 1792 + c : out + O_SSHIFT + (size_t)(l * 128 + sq - 8) * 1792 + c;
            *(float4*)dst = make_float4(lo2f(u.x), hi2f(u.x), lo2f(u.y), hi2f(u.y));
        }
        for (size_t i = gt; i < (size_t)136 * 15 * 128; i += gs) {
            const int c = (int)(i & 127) * 4, r = (int)((i >> 7) % 15), sq = (int)((i >> 7) / 15);
            const int b = sq < 8 ? 0 : sq - 8;
            const int row = sq < 8 ? sq * 2048 + 2033 + r : TPROMPT + b * 8 + (r >= 7 ? r - 7 : 0);
            const uint2 u = *(const uint2*)(P + (size_t)row * PW + PB + c);
            const float4 sp = *(const float4*)(p->in[I_SPOOL] + ((size_t)(l * 128 + b) * 15 + (r < 7 ? 8 + r : 0)) * 512 + c);
            float4 v = make_float4(lo2f(u.x), hi2f(u.x), lo2f(u.y), hi2f(u.y));
            if (sq >= 8 && r < 7) v = sp;
            float* dst = sq < 8 ? out + O_PPOOL + ((size_t)(l * 8 + sq) * 15 + r) * 512 + c : out + O_SPOOL + ((size_t)(l * 128 + b) * 15 + r) * 512 + c;
            *(float4*)dst = v;
        }
        for (size_t i = gt; i < (size_t)136 * 3 * 384; i += gs) {
            const int c = (int)(i % 384) * 4, r = (int)((i / 384) % 3), sq = (int)(i / (3 * 384));
            const int row = sq < 8 ? sq * 2048 + 2045 + r : TPROMPT + (sq - 8) * 8 + 5 + r;
            const uint2 u = *(const uint2*)(P + (size_t)row * PW + PC + c);
            float* dst = sq < 8 ? out + O_PCONV + ((size_t)(l * 8 + sq) * 3 + r) * 1536 + c : out + O_SCONV + ((size_t)(l * 128 + sq - 8) * 3 + r) * 1536 + c;
            *(float4*)dst = make_float4(lo2f(u.x), hi2f(u.x), lo2f(u.y), hi2f(u.y));
        }
    }
}
__device__ __forceinline__ void phase_prep(KP p, int l, unsigned char* smem) {
    const int tid_ = tidx();
    const int wid = tid_ >> 6;
    for (int t = blockIdx.x; t < 1088 * 2; t += gridDim.x) rwkv_prep_task(p, l, t >> 1, t & 1, (bf16_t*)smem);
    const int gw = blockIdx.x * 4 + wid, nw = gridDim.x * 4;
    for (int q = gw; q < TPROMPT / 4 + (NTOK - TPROMPT); q += nw) {
        if (q < TPROMPT / 4) {
            const int R0 = q * 4;
            if ((R0 & 2047) == 0) { for (int k = 0; k < 4; ++k) delta_prep_row(p, l, R0 + k); }
            else delta_prep_quad(p, l, R0);
        } else delta_prep_row(p, l, TPROMPT + (q - TPROMPT / 4));
    }
}

typedef float f32x2 __attribute__((ext_vector_type(2)));
__device__ __forceinline__ float red8(float v) {
    v += dpp_mov<0xB1>(v);
    v += dpp_mov<0x4E>(v);
    v += dpp_mov<0x141>(v);
    return v;
}
__device__ __forceinline__ void rwkv_scan_task(KP p, int l, bool samp, int b, int h, int hb, float* sm) {
    const int tid_ = tidx();
    const int tid = tid_, lane = tid & 63, wid = tid >> 6, rr = lane >> 3, ks = lane & 7;
    const int L = samp ? 8 : 2048, row0 = samp ? TPROMPT + b * 8 : b * 2048;
    const int vrow = hb * 32 + wid * 8 + rr;
    const float* Rw = (const float*)(p->ws + OFF_RW);
    const bf16_t* Rkk = (const bf16_t*)(p->ws + OFF_RKK); const bf16_t* Rka = (const bf16_t*)(p->ws + OFF_RKA);
    const bf16_t* Rkp = (const bf16_t*)(p->ws + OFF_RKP); const bf16_t* Rr = (const bf16_t*)(p->ws + OFF_RR);
    const bf16_t* Rv = (const bf16_t*)(p->ws + OFF_RV);
    float* yraw = (float*)(p->ws + OFF_Y);
    f32x2 S[4];
#pragma unroll
    for (int i = 0; i < 4; ++i) S[i] = (f32x2){0.f, 0.f};
    if (samp) {
        const float* sp = p->in[I_SRWKV] + ((size_t)((l * 128 + b) * 8 + h) * 64 + vrow) * 64 + ks * 8;
        const float4 s0 = *(const float4*)sp, s1 = *(const float4*)(sp + 4);
        S[0] = (f32x2){s0.x, s0.y}; S[1] = (f32x2){s0.z, s0.w}; S[2] = (f32x2){s1.x, s1.y}; S[3] = (f32x2){s1.z, s1.w};
    }
    const int sstep = tid >> 4, sc = tid & 15;
    float4 pw; uint2 pkk, pka, pkp, pr; unsigned pv;
    const int ntile = (L + 15) >> 4;
    auto load_tile = [&](int tile) {
        const int step = tile * 16 + sstep;
        if (step < L) {
            const size_t o = (size_t)(row0 + step) * 512 + h * 64 + sc * 4;
            pw = *(const float4*)(Rw + o);
            pkk = *(const uint2*)(Rkk + o); pka = *(const uint2*)(Rka + o); pkp = *(const uint2*)(Rkp + o); pr = *(const uint2*)(Rr + o);
            pv = *(const unsigned*)(Rv + (size_t)(row0 + step) * 512 + h * 64 + hb * 32 + sc * 2);
        }
    };
    load_tile(0);
    for (int tile = 0; tile < ntile; ++tile) {
        float* bufp = sm + (tile & 1) * 5632;
        {
            const int o = sstep * 64 + sc * 4;
            *(float4*)(bufp + o) = pw;
            *(float4*)(bufp + 1024 + o) = make_float4(lo2f(pkk.x), hi2f(pkk.x), lo2f(pkk.y), hi2f(pkk.y));
            *(float4*)(bufp + 2048 + o) = make_float4(lo2f(pka.x), hi2f(pka.x), lo2f(pka.y), hi2f(pka.y));
            *(float4*)(bufp + 3072 + o) = make_float4(lo2f(pkp.x), hi2f(pkp.x), lo2f(pkp.y), hi2f(pkp.y));
            *(float4*)(bufp + 4096 + o) = make_float4(lo2f(pr.x), hi2f(pr.x), lo2f(pr.y), hi2f(pr.y));
            *(float2*)(bufp + 5120 + sstep * 32 + sc * 2) = make_float2(lo2f(pv), hi2f(pv));
        }
        __syncthreads();
        if (tile + 1 < ntile) load_tile(tile + 1);
        const int nst = (L - tile * 16) < 16 ? (L - tile * 16) : 16;
        for (int s0 = 0; s0 < nst; s0 += 4) {
#pragma unroll
            for (int s4 = 0; s4 < 4; ++s4) {
                const int s = s0 + s4;
                const float* bs = bufp + s * 64 + ks * 8;
                f32x2 w2[4], kk2[4], ka2[4], kp2[4], r2[4];
#pragma unroll
                for (int hh = 0; hh < 2; ++hh) {
                    const float4 a = *(const float4*)(bs + hh * 4);
                    const float4 bq = *(const float4*)(bs + 1024 + hh * 4);
                    const float4 c = *(const float4*)(bs + 2048 + hh * 4);
                    const float4 d = *(const float4*)(bs + 3072 + hh * 4);
                    const float4 e = *(const float4*)(bs + 4096 + hh * 4);
                    w2[2 * hh] = (f32x2){a.x, a.y}; w2[2 * hh + 1] = (f32x2){a.z, a.w};
                    kk2[2 * hh] = (f32x2){bq.x, bq.y}; kk2[2 * hh + 1] = (f32x2){bq.z, bq.w};
                    ka2[2 * hh] = (f32x2){c.x, c.y}; ka2[2 * hh + 1] = (f32x2){c.z, c.w};
                    kp2[2 * hh] = (f32x2){d.x, d.y}; kp2[2 * hh + 1] = (f32x2){d.z, d.w};
                    r2[2 * hh] = (f32x2){e.x, e.y}; r2[2 * hh + 1] = (f32x2){e.z, e.w};
                }
                const float vv = bufp[5120 + s * 32 + wid * 8 + rr];
                const f32x2 vv2 = (f32x2){vv, vv};
                f32x2 da = S[0] * kk2[0], db = S[1] * kk2[1];
                da = S[2] * kk2[2] + da; db = S[3] * kk2[3] + db;
                da = da + db;
                f32x2 u2[4];
#pragma unroll
                for (int i = 0; i < 4; ++i) u2[i] = S[i] * w2[i] + vv2 * kp2[i];
                const float d1 = red8(da.x + da.y);
                const f32x2 nd = (f32x2){-d1, -d1};
#pragma unroll
                for (int i = 0; i < 4; ++i) S[i] = nd * ka2[i] + u2[i];
                f32x2 ya = S[0] * r2[0], yb = S[1] * r2[1];
                ya = S[2] * r2[2] + ya; yb = S[3] * r2[3] + yb;
                ya = ya + yb;
                const float y = red8(ya.x + ya.y);
                yraw[(size_t)(row0 + tile * 16 + s) * 512 + h * 64 + vrow] = y;
            }
        }
    }
    float* so = (samp ? p->out + O_SRWKV + ((size_t)((l * 128 + b) * 8 + h) * 64 + vrow) * 64
                      : p->out + O_PRWKV + ((size_t)((l * 8 + b) * 8 + h) * 64 + vrow) * 64) + ks * 8;
    *(float4*)so = make_float4(S[0].x, S[0].y, S[1].x, S[1].y);
    *(float4*)(so + 4) = make_float4(S[2].x, S[2].y, S[3].x, S[3].y);
    __syncthreads();
}

__device__ __forceinline__ void delta_scan_task(KP p, int l, bool samp, int b, int h, int cgp, float* sm) {
    const int tid_ = tidx();
    const int tid = tid_, lane = tid & 63, wid = tid >> 6, cc = lane >> 3, ks = lane & 7;
    const int L = samp ? 8 : 2048, row0 = samp ? TPROMPT + b * 8 : b * 2048;
    const int e = cgp * 32 + wid * 8 + cc;
    const bf16_t* Dq = (const bf16_t*)(p->ws + OFF_DQ); const bf16_t* Dk = (const bf16_t*)(p->ws + OFF_DK); const bf16_t* Dv = (const bf16_t*)(p->ws + OFF_DV);
    const float* Dsc = (const float*)(p->ws + OFF_DSC);
    float* oraw = (float*)(p->ws + OFF_Y) + (size_t)NTOK * 512;
    f32x2 S[8];
    const size_t sbase = samp ? ((size_t)((l * 128 + b) * 4 + h) * 128) * 128 : ((size_t)((l * 8 + b) * 4 + h) * 128) * 128;
#pragma unroll
    for (int j = 0; j < 8; ++j) {
        S[j] = (f32x2){0.f, 0.f};
        if (samp) {
            S[j].x = p->in[I_SDELTA][sbase + (size_t)(ks * 16 + 2 * j) * 128 + e];
            S[j].y = p->in[I_SDELTA][sbase + (size_t)(ks * 16 + 2 * j + 1) * 128 + e];
        }
    }
    const int sstep = tid >> 4, sc = tid & 15;
    uint4 pk, pq; unsigned pv; float2 psc;
    const int ntile = (L + 15) >> 4;
    auto load_tile = [&](int tile) {
        const int step = tile * 16 + sstep;
        if (step < L) {
            const size_t o = (size_t)(row0 + step) * 512 + h * 128 + sc * 8;
            pk = *(const uint4*)(Dk + o); pq = *(const uint4*)(Dq + o);
            pv = *(const unsigned*)(Dv + (size_t)(row0 + step) * 512 + h * 128 + cgp * 32 + sc * 2);
        }
        if (tid < 16 && tile * 16 + tid < L) psc = *(const float2*)(Dsc + ((size_t)(row0 + tile * 16 + tid) * 4 + h) * 2);
    };
    load_tile(0);
    for (int tile = 0; tile < ntile; ++tile) {
        float* bufp = sm + (tile & 1) * 4640;
        {
            const int o = sstep * 128 + sc * 8;
            *(float4*)(bufp + o) = make_float4(lo2f(pk.x), hi2f(pk.x), lo2f(pk.y), hi2f(pk.y));
            *(float4*)(bufp + o + 4) = make_float4(lo2f(pk.z), hi2f(pk.z), lo2f(pk.w), hi2f(pk.w));
            *(float4*)(bufp + 2048 + o) = make_float4(lo2f(pq.x), hi2f(pq.x), lo2f(pq.y), hi2f(pq.y));
            *(float4*)(bufp + 2048 + o + 4) = make_float4(lo2f(pq.z), hi2f(pq.z), lo2f(pq.w), hi2f(pq.w));
            *(float2*)(bufp + 4096 + sstep * 32 + sc * 2) = make_float2(lo2f(pv), hi2f(pv));
            if (tid < 16) { bufp[4608 + tid] = psc.x; bufp[4624 + tid] = psc.y; }
        }
        __syncthreads();
        if (tile + 1 < ntile) load_tile(tile + 1);
        const int nst = (L - tile * 16) < 16 ? (L - tile * 16) : 16;
        for (int s0 = 0; s0 < nst; s0 += 4) {
#pragma unroll
            for (int s4 = 0; s4 < 4; ++s4) {
                const int s = s0 + s4;
                f32x2 k2[8], q2[8];
#pragma unroll
                for (int hh = 0; hh < 4; ++hh) {
                    const float4 a = *(const float4*)(bufp + s * 128 + ks * 16 + hh * 4);
                    const float4 c = *(const float4*)(bufp + 2048 + s * 128 + ks * 16 + hh * 4);
                    k2[2 * hh] = (f32x2){a.x, a.y}; k2[2 * hh + 1] = (f32x2){a.z, a.w};
                    q2[2 * hh] = (f32x2){c.x, c.y}; q2[2 * hh + 1] = (f32x2){c.z, c.w};
                }
                const float vv = bufp[4096 + s * 32 + wid * 8 + cc];
                const float beta = bufp[4608 + s], alpha = bufp[4624 + s];
                f32x2 d0 = S[0] * k2[0], d1v = S[1] * k2[1], d2 = S[2] * k2[2], d3 = S[3] * k2[3];
                d0 = S[4] * k2[4] + d0; d1v = S[5] * k2[5] + d1v; d2 = S[6] * k2[6] + d2; d3 = S[7] * k2[7] + d3;
                d0 = (d0 + d1v) + (d2 + d3);
                const f32x2 al2 = (f32x2){alpha, alpha};
                f32x2 sa[8];
#pragma unroll
                for (int j = 0; j < 8; ++j) sa[j] = S[j] * al2;
                const float dk = red8(d0.x + d0.y);
                const float vn = beta * (vv - alpha * dk);
                const f32x2 vn2 = (f32x2){vn, vn};
#pragma unroll
                for (int j = 0; j < 8; ++j) S[j] = k2[j] * vn2 + sa[j];
                f32x2 o0 = S[0] * q2[0], o1 = S[1] * q2[1], o2 = S[2] * q2[2], o3 = S[3] * q2[3];
                o0 = S[4] * q2[4] + o0; o1 = S[5] * q2[5] + o1; o2 = S[6] * q2[6] + o2; o3 = S[7] * q2[7] + o3;
                o0 = (o0 + o1) + (o2 + o3);
                const float o = red8(o0.x + o0.y);
                oraw[(size_t)(row0 + tile * 16 + s) * 512 + h * 128 + e] = o;
            }
        }
    }
    float* so = (samp ? p->out + O_SDELTA : p->out + O_PDELTA) + sbase;
#pragma unroll
    for (int j = 0; j < 8; ++j) {
        so[(size_t)(ks * 16 + 2 * j) * 128 + e] = S[j].x;
        so[(size_t)(ks * 16 + 2 * j + 1) * 128 + e] = S[j].y;
    }
    __syncthreads();
}

__device__ __forceinline__ void phase_scan(KP p, int l, unsigned char* smem) {
    __shared__ int s_q;
    const int tid_ = tidx();
    const int NLONG = 256, NT_RS = 2048, NT_DS = 2048;
    const int G = gridDim.x, bid = blockIdx.x;
    const bool split = G >= 2 * NLONG;
    if (split && bid < NLONG) {
        if (bid < 128) rwkv_scan_task(p, l, false, bid >> 4, (bid >> 1) & 7, bid & 1, (float*)smem);
        else { const int u = bid - 128; delta_scan_task(p, l, false, u >> 4, (u >> 2) & 3, u & 3, (float*)smem); }
    } else {
        const int first = split ? bid - NLONG : bid, stride = split ? G - NLONG : G;
        const int total = (split ? 0 : NLONG) + NT_RS + NT_DS;
        for (int t = first; t < total; t += stride) {
            int u = t;
            if (!split) {
                if (u < 128) { rwkv_scan_task(p, l, false, u >> 4, (u >> 1) & 7, u & 1, (float*)smem); continue; }
                if (u < 256) { const int v = u - 128; delta_scan_task(p, l, false, v >> 4, (v >> 2) & 3, v & 3, (float*)smem); continue; }
                u -= NLONG;
            }
            if (u < NT_RS) { rwkv_scan_task(p, l, true, u >> 4, (u >> 1) & 7, u & 1, (float*)smem); continue; }
            u -= NT_RS;
            delta_scan_task(p, l, true, u >> 4, (u >> 2) & 3, u & 3, (float*)smem);
        }
    }
    unsigned* cnt = (unsigned*)(p->ws + OFF_CNT) + l * 64;
    for (;;) {
        __syncthreads();
        if (tid_ == 0) s_q = (int)atomicAdd(cnt, 1u);
        __syncthreads();
        const int t = s_q;
        const int NGT = 136 * 32, NAT = 1152, NMV = 256;
        if (t >= NGT + NAT + NMV) break;
        if (t < NMV) misc_vblock(p, l, t, NMV);
        else if (t < NMV + NAT) attn_block_task(p, l, t - NMV);
        else gate_tile(t - NMV - NAT, (const bf16_t*)(p->ws + OFF_XB), (const bf16_t*)(p->ws + OFF_WG), (bf16_t*)(p->ws + OFF_G), (bf16_t*)smem);
    }
}

__device__ __forceinline__ void phase_post(KP p, int l, unsigned char* smem) {
    for (int t = blockIdx.x; t < 544; t += gridDim.x) {
        pool_gemm_tile(t, (const bf16_t*)(p->ws + OFF_POOLED), (const bf16_t*)(p->ws + OFF_POOLT), p->in[I_POOLS] + l * 512,
                       (bf16_t*)(p->ws + OFF_BO), (bf16_t*)smem);
        __syncthreads();
    }
    const int tid_ = tidx();
    const int lane = tid_ & 63, wid = tid_ >> 6;
    bf16_t* BO = (bf16_t*)(p->ws + OFF_BO);
    const float* yraw = (const float*)(p->ws + OFF_Y);
    const float* oraw = yraw + (size_t)NTOK * 512;
    const bf16_t* Rv = (const bf16_t*)(p->ws + OFF_RV); const bf16_t* Rg = (const bf16_t*)(p->ws + OFF_RG);
    const bf16_t* SZ = (const bf16_t*)(p->ws + OFF_SZ);
    const float* Rc = (const float*)(p->ws + OFF_RC);
    const int c0 = lane * 8;
    float gw[8], gb[8], nw[8];
    {
        const float4 a = *(const float4*)(p->in[I_GNW] + l * 512 + c0), a2 = *(const float4*)(p->in[I_GNW] + l * 512 + c0 + 4);
        const float4 bq = *(const float4*)(p->in[I_GNB] + l * 512 + c0), b2 = *(const float4*)(p->in[I_GNB] + l * 512 + c0 + 4);
        const float4 n1 = *(const float4*)(p->in[I_NORMW] + l * 128 + (c0 & 127)), n2 = *(const float4*)(p->in[I_NORMW] + l * 128 + (c0 & 127) + 4);
        gw[0] = a.x; gw[1] = a.y; gw[2] = a.z; gw[3] = a.w; gw[4] = a2.x; gw[5] = a2.y; gw[6] = a2.z; gw[7] = a2.w;
        gb[0] = bq.x; gb[1] = bq.y; gb[2] = bq.z; gb[3] = bq.w; gb[4] = b2.x; gb[5] = b2.y; gb[6] = b2.z; gb[7] = b2.w;
        nw[0] = n1.x; nw[1] = n1.y; nw[2] = n1.z; nw[3] = n1.w; nw[4] = n2.x; nw[5] = n2.y; nw[6] = n2.z; nw[7] = n2.w;
    }
    for (int R = blockIdx.x * 4 + wid; R < NTOK; R += gridDim.x * 4) {
        const size_t o = (size_t)R * 512 + c0;
        const float4 y0 = *(const float4*)(yraw + o), y1 = *(const float4*)(yraw + o + 4);
        const float4 d0 = *(const float4*)(oraw + o), d1 = *(const float4*)(oraw + o + 4);
        const u32x4 rv = *(const u32x4*)(Rv + o), rg = *(const u32x4*)(Rg + o), sz = *(const u32x4*)(SZ + o);
        const float bon = Rc[(size_t)R * 8 + (lane >> 3)];
        float y[8] = {y0.x, y0.y, y0.z, y0.w, y1.x, y1.y, y1.z, y1.w};
        float dl[8] = {d0.x, d0.y, d0.z, d0.w, d1.x, d1.y, d1.z, d1.w};
        float s = 0.f;
#pragma unroll
        for (int j = 0; j < 8; ++j) s += y[j];
        const float mean = red8(s) * (1.f / 64.f);
        float q = 0.f, dq = 0.f;
#pragma unroll
        for (int j = 0; j < 8; ++j) { y[j] -= mean; q += y[j] * y[j]; dq += dl[j] * dl[j]; }
        const float rstd = rsqrtf(red8(q) * (1.f / 64.f) + 64e-5f);
        const float rs = rsqrtf(red16(dq) * (1.f / 128.f) + 1e-6f);
        float oa[8], oc[8];
#pragma unroll
        for (int j = 0; j < 8; ++j) {
            const unsigned vu = rv[j >> 1], gu = rg[j >> 1], zu = sz[j >> 1];
            const float vv = (j & 1) ? hi2f(vu) : lo2f(vu), gg = (j & 1) ? hi2f(gu) : lo2f(gu), zz = (j & 1) ? hi2f(zu) : lo2f(zu);
            oa[j] = (y[j] * rstd * gw[j] + gb[j] + bon * vv) * gg;
            oc[j] = dl[j] * rs * nw[j] * zz;
        }
        u32x4 pa, pc;
#pragma unroll
        for (int j = 0; j < 4; ++j) { pa[j] = pack2(oa[2 * j], oa[2 * j + 1]); pc[j] = pack2(oc[2 * j], oc[2 * j + 1]); }
        *(u32x4*)(BO + (size_t)R * 1792 + c0) = pa;
        *(u32x4*)(BO + (size_t)R * 1792 + 1024 + c0) = pc;
    }
}

__device__ __forceinline__ void run_phase(KP p, int ph, unsigned char* smem) {
    unsigned char* ws = p->ws;
    bf16_t* xb = (bf16_t*)(ws + OFF_XB);
    float* X = p->out;
    float* Y = (float*)(ws + OFF_Y);
    bf16_t* P = (bf16_t*)(ws + OFF_P);
    bf16_t* H = P;
    const bool init = ph == 0;
    const int l = init ? 0 : (ph - 1) / NPH_LAYER, s = init ? -1 : (ph - 1) % NPH_LAYER;
    if (s == 0 || s == 10) {
        phase_ffn_in(xb, (const bf16_t*)(ws + (s == 0 ? OFF_WF1I : OFF_WF2I)), H, (bf16_t*)smem);
        if (s == 0 && l == 0) phase_memkv(p, (bf16_t*)smem);
    } else if (s == 1 || s == 8 || s == 11) {
        const bf16_t* A = s == 8 ? (const bf16_t*)(ws + OFF_MERGED) : H;
        const int K = s == 8 ? 1024 : 2048;
        const bf16_t* W = (const bf16_t*)(ws + (s == 1 ? OFF_WF1O : (s == 8 ? OFF_WO : OFF_WF2O)));
        phase_gemm_resid(A, K, K, W, X, Y, s == 8 ? 1.0f : 0.5f, (bf16_t*)smem);
    } else if (init || s == 2 || s == 9 || s == 12) {
        if (!init) {
            const int li = s == 2 ? 0 : (s == 9 ? 1 : 2);
            phase_ln(Y, X, xb, p->in[I_LNG] + (l * 3 + li) * 1024, p->in[I_LNB] + (l * 3 + li) * 1024);
        }
        if (s == 2) conv_sample_kv(p, l);
        if (init) phase_init(p, (float*)smem);
        if (init || (s == 12 && l < 3)) convert_layer_weights(p, init ? 0 : l + 1, (float*)smem);
    } else if (s == 3) {
        phase_proj(xb, (const bf16_t*)(ws + OFF_WP), P, (bf16_t*)smem);
    } else if (s == 4) {
        phase_prep(p, l, smem);
    } else if (s == 5) {
        phase_scan(p, l, smem);
    } else if (s == 6) {
        phase_post(p, l, smem);
    } else {
        phase_merge((const bf16_t*)(ws + OFF_G), (const bf16_t*)(ws + OFF_BO), (const bf16_t*)(ws + OFF_WB), (bf16_t*)(ws + OFF_MERGED), (bf16_t*)smem);
    }
}

#define XB_TMO      128
#define XB_XCNT(j)  (256  + 64 * (j))
#define XB_XSUB(j)  (1280 + 64 * (j))
#define XB_XGEN(j)  (2304 + 64 * (j))
#define XB_TOP      3328
#define XB_TOPGEN   3392
#define XCD_BAR_WORDS 3456
#define XB_SPIN_CAP (1u << 22)
#define LAS __attribute__((address_space(3)))
__device__ __forceinline__ unsigned xb_ld(unsigned* p)              { return __hip_atomic_load(p, __ATOMIC_RELAXED, __HIP_MEMORY_SCOPE_AGENT); }
__device__ __forceinline__ unsigned xb_add(unsigned* p, unsigned v) { return __hip_atomic_fetch_add(p, v, __ATOMIC_RELAXED, __HIP_MEMORY_SCOPE_AGENT); }
__device__ __forceinline__ unsigned xb_xcc_id() { return (unsigned)__builtin_amdgcn_s_getreg((3 << 11) | 20) & 0xFu; }
#define XB_SPIN(cond, bar) do { unsigned _sp = 0; while (cond) { __builtin_amdgcn_s_sleep(1); \
    if ((++_sp & 255u) == 0u) { if (xb_ld(&(bar)[XB_TMO])) break; if (_sp > XB_SPIN_CAP) { atomicAdd(&(bar)[XB_TMO], 1u); break; } } } } while (0)
struct XcdBarrier { unsigned* bar; unsigned x; volatile LAS unsigned* st; };
__device__ __forceinline__ XcdBarrier xcd_barrier_post(unsigned* bar, volatile LAS unsigned* st) {
    XcdBarrier b; b.bar = bar; b.x = xb_xcc_id(); b.st = st;
    if (threadIdx.x == 0) (void)xb_add(&bar[XB_XCNT(b.x)], 1u);
    return b;
}
__device__ __forceinline__ void xcd_barrier_complete(unsigned* bar, unsigned x, unsigned& nloc, unsigned& nx) {
    const unsigned G = gridDim.x * gridDim.y * gridDim.z;
    unsigned sum, cnt, mine, sp = 0u;
    for (;;) {
        sum = 0u; cnt = 0u; mine = 0u;
#pragma unroll
        for (unsigned j = 0; j < 16; ++j) { const unsigned c = xb_ld(&bar[XB_XCNT(j)]); sum += c; cnt += (c > 0u) ? 1u : 0u; mine = (j == x) ? c : mine; }
        if (sum == G) break;
        __builtin_amdgcn_s_sleep(1);
        if ((++sp & 255u) == 0u) { if (xb_ld(&bar[XB_TMO])) break; if (sp > XB_SPIN_CAP) { atomicAdd(&bar[XB_TMO], 1u); break; } }
    }
    nloc = mine > 0u ? mine : 1u; nx = cnt > 0u ? cnt : 1u;
}
__device__ __forceinline__ void xcd_barrier(const XcdBarrier& b) {
    asm volatile("s_waitcnt vmcnt(0)" ::: "memory");
    __syncthreads();
    if (threadIdx.x == 0) {
        unsigned* bar = b.bar;
        __builtin_amdgcn_s_waitcnt(0);
        unsigned nloc = b.st[0], nx = b.st[1];
        if (nloc == 0u) { xcd_barrier_complete(bar, b.x, nloc, nx); b.st[0] = nloc; b.st[1] = nx; }
        const unsigned old = xb_add(&bar[XB_XSUB(b.x)], 1u);
        const unsigned gen = old / nloc;
        if (old + 1u == (gen + 1u) * nloc) {
            __builtin_amdgcn_fence(__ATOMIC_RELEASE, "agent");
            asm volatile("s_waitcnt vmcnt(0)" ::: "memory");
            const unsigned og = xb_add(&bar[XB_TOP], 1u);
            const unsigned tg = og / nx;
            if (og + 1u == (tg + 1u) * nx) xb_add(&bar[XB_TOPGEN], 1u);
            else XB_SPIN(xb_ld(&bar[XB_TOPGEN]) == tg, bar);
            __builtin_amdgcn_fence(__ATOMIC_ACQUIRE, "agent");
            xb_add(&bar[XB_XGEN(b.x)], 1u);
            asm volatile("s_waitcnt vmcnt(0)" ::: "memory");
        } else {
            XB_SPIN(xb_ld(&bar[XB_XGEN(b.x)]) == gen, bar);
            __builtin_amdgcn_fence(__ATOMIC_ACQUIRE, "agent");
            asm volatile("s_waitcnt vmcnt(0)" ::: "memory");
        }
    }
    __syncthreads();
}

__global__ void __launch_bounds__(256, 3) mega(Params p, int ph_lo, int ph_hi) {
    __shared__ __attribute__((aligned(16))) unsigned char smem[45056];
    __shared__ uint4 xb_words;
    cg::grid_group grid = cg::this_grid();
    if (threadIdx.x == 0) xb_words = make_uint4(0u, 0u, 0u, 0u);
    __syncthreads();
    KP kp0 = (KP)__builtin_amdgcn_kernarg_segment_ptr();
    XcdBarrier xb = xcd_barrier_post((unsigned*)(kp0->ws + OFF_BAR), (volatile LAS unsigned*)&xb_words);
    if (ph_hi > 100000) grid.sync();
    for (int ph = ph_lo; ph < ph_hi; ++ph) {
#ifdef REPEAT_MASK
        const int nrep = (ph > 0 && ((REPEAT_MASK >> ((ph - 1) % NPH_LAYER)) & 1)) ? 2 : 1;
        for (int rep = 0; rep < nrep; ++rep)
#endif
        { KP kq = kp0; asm volatile("" : "+s"(kq)); run_phase(kq, ph, smem); }
        if (ph + 1 < ph_hi) xcd_barrier(xb);
    }
}

extern "C" void kernel_launch(void* const* d_in, const int* in_sizes, int n_in, void* d_out, int out_size, void* d_ws, size_t ws_size,
                              hipStream_t stream) {
    Params p{};
    for (int i = 0; i < 37; ++i) p.in[i] = (const float*)d_in[i];
    p.out = (float*)d_out; p.ws = (unsigned char*)d_ws;
    static int grid_blocks = 0;
    if (!grid_blocks) {
        int dev = 0, cus = 0, per_cu = 0;
        hipGetDevice(&dev);
        hipDeviceGetAttribute(&cus, hipDeviceAttributeMultiprocessorCount, dev);
        hipOccupancyMaxActiveBlocksPerMultiprocessor(&per_cu, mega, 256, 0);
        if (per_cu > 3) per_cu = 3;
        if (per_cu < 1) per_cu = 1;
        grid_blocks = cus * per_cu;
    }
    if (ws_size < WS_TOTAL) { fprintf(stderr, "workspace too small\n"); return; }
    (void)hipMemsetAsync((unsigned char*)d_ws + OFF_BAR, 0, (OFF_CNT - OFF_BAR) + 1024, stream);
#if MULTI_LAUNCH
    for (int ph = 0; ph < NPHASES; ++ph) {
        int lo = ph, hi = ph + 1;
        hipLaunchKernelGGL(mega, dim3(grid_blocks), dim3(256), 0, stream, p, lo, hi);
    }
#else
    int lo = 0, hi = NPHASES;
    void* args[] = {&p, &lo, &hi};
    hipError_t e = hipLaunchCooperativeKernel((void*)mega, dim3(grid_blocks), dim3(256), args, 0, stream);
    if (e != hipSuccess) fprintf(stderr, "cooperative launch failed: %s (grid %d)\n", hipGetErrorString(e), grid_blocks);
#endif
}
```

```cpp
#include <hip/hip_runtime.h>
#include <hip/hip_cooperative_groups.h>
#include <stdint.h>
#include <cstdio>
namespace cg = cooperative_groups;

typedef unsigned short bf16_t;
typedef short bf16x8 __attribute__((ext_vector_type(8)));
typedef float f32x4 __attribute__((ext_vector_type(4)));
typedef unsigned u32x4 __attribute__((ext_vector_type(4)));

#ifndef MULTI_LAUNCH
#define MULTI_LAUNCH 0
#endif

constexpr int NTOK = 17408;
constexpr int TPROMPT = 16384;
constexpr int PW = 4736;
constexpr int PB = 1792, PC = 2304, PM = 4352, PBA = 4608;
constexpr float ALPHA = 1.6817928305074292f;
constexpr int NPH_LAYER = 13;
constexpr int NPHASES = 1 + 4 * NPH_LAYER;

constexpr size_t O_YP = 0;
constexpr size_t O_YS = O_YP + (size_t)8 * 2048 * 1024;
constexpr size_t O_PRWKV = O_YS + (size_t)128 * 8 * 1024;
constexpr size_t O_PSHIFT = O_PRWKV + (size_t)4 * 8 * 8 * 4096;
constexpr size_t O_PPOOL = O_PSHIFT + (size_t)4 * 8 * 1792;
constexpr size_t O_PDELTA = O_PPOOL + (size_t)4 * 8 * 15 * 512;
constexpr size_t O_PCONV = O_PDELTA + (size_t)4 * 8 * 4 * 16384;
constexpr size_t O_PMK = O_PCONV + (size_t)4 * 8 * 3 * 1536;
constexpr size_t O_PMV = O_PMK + (size_t)4 * 8 * 256 * 256;
constexpr size_t O_SRWKV = O_PMV + (size_t)4 * 8 * 256 * 256;
constexpr size_t O_SSHIFT = O_SRWKV + (size_t)4 * 128 * 8 * 4096;
constexpr size_t O_SPOOL = O_SSHIFT + (size_t)4 * 128 * 1792;
constexpr size_t O_SDELTA = O_SPOOL + (size_t)4 * 128 * 15 * 512;
constexpr size_t O_SCONV = O_SDELTA + (size_t)4 * 128 * 4 * 16384;

constexpr size_t al(size_t x) { return (x + 255) & ~(size_t)255; }
constexpr size_t OFF_WF1I = 0;
constexpr size_t OFF_WF1O = OFF_WF1I + al((size_t)4096 * 1024 * 2);
constexpr size_t OFF_WF2I = OFF_WF1O + al((size_t)1024 * 2048 * 2);
constexpr size_t OFF_WF2O = OFF_WF2I + al((size_t)4096 * 1024 * 2);
constexpr size_t OFF_WP = OFF_WF2O + al((size_t)1024 * 2048 * 2);
constexpr size_t OFF_WG = OFF_WP + al((size_t)PW * 1024 * 2);
constexpr size_t OFF_WB = OFF_WG + al((size_t)4096 * 1024 * 2);
constexpr size_t OFF_WO = OFF_WB + al((size_t)1024 * 1792 * 2);
constexpr size_t OFF_POOLT = OFF_WO + al((size_t)1024 * 1024 * 2);
constexpr size_t OFF_WUP = OFF_POOLT + al((size_t)4 * 128 * 128 * 2);
constexpr size_t OFF_AUP = OFF_WUP + al((size_t)512 * 64 * 2);
constexpr size_t OFF_GUP = OFF_AUP + al((size_t)512 * 64 * 2);
constexpr size_t OFF_WKV = OFF_GUP + al((size_t)512 * 128 * 2);
constexpr size_t OFF_MEMB = OFF_WKV + al((size_t)4 * 512 * 1024 * 2);
constexpr size_t OFF_KP = OFF_MEMB + al((size_t)2048 * 1024 * 2);
constexpr size_t OFF_VTP = OFF_KP + al((size_t)4 * 8 * 4 * 16384 * 2);
constexpr size_t OFF_KS = OFF_VTP + al((size_t)4 * 8 * 4 * 16384 * 2);
constexpr size_t OFF_VTS = OFF_KS + al((size_t)128 * 4 * 16384 * 2);
constexpr size_t OFF_XB = OFF_VTS + al((size_t)128 * 4 * 16384 * 2);
constexpr size_t OFF_Y = OFF_XB + al((size_t)NTOK * 1024 * 2);
constexpr size_t OFF_P = OFF_Y + al((size_t)NTOK * 1024 * 4);
constexpr size_t OFF_BO = OFF_P + al((size_t)NTOK * PW * 2);
constexpr size_t OFF_MERGED = OFF_BO + al((size_t)NTOK * 1792 * 2);
constexpr size_t OFF_POOLED = OFF_MERGED + al((size_t)NTOK * 1024 * 2);
constexpr size_t OFF_RW = OFF_POOLED + al((size_t)NTOK * 512 * 2);
constexpr size_t OFF_RKK = OFF_RW + al((size_t)NTOK * 512 * 4);
constexpr size_t OFF_RKA = OFF_RKK + al((size_t)NTOK * 512 * 2);
constexpr size_t OFF_RKP = OFF_RKA + al((size_t)NTOK * 512 * 2);
constexpr size_t OFF_RR = OFF_RKP + al((size_t)NTOK * 512 * 2);
constexpr size_t OFF_RV = OFF_RR + al((size_t)NTOK * 512 * 2);
constexpr size_t OFF_RG = OFF_RV + al((size_t)NTOK * 512 * 2);
constexpr size_t OFF_RC = OFF_RG + al((size_t)NTOK * 512 * 2);
constexpr size_t OFF_DQ = OFF_RC + al((size_t)NTOK * 8 * 4);
constexpr size_t OFF_DK = OFF_DQ + al((size_t)NTOK * 512 * 2);
constexpr size_t OFF_DV = OFF_DK + al((size_t)NTOK * 512 * 2);
constexpr size_t OFF_DSC = OFF_DV + al((size_t)NTOK * 512 * 2);
constexpr size_t OFF_BAR = OFF_DSC + al((size_t)NTOK * 4 * 2 * 4);
constexpr size_t OFF_CNT = OFF_BAR + al((size_t)3456 * 4);
constexpr size_t OFF_SZ = OFF_CNT + 1024;
constexpr size_t OFF_G = OFF_SZ + al((size_t)NTOK * 512 * 2);
constexpr size_t WS_TOTAL = OFF_G + al((size_t)NTOK * 4096 * 2);

struct Params { const float* in[37]; float* out; unsigned char* ws; };
typedef const __attribute__((address_space(4))) Params* KP;

enum { I_XP = 0, I_XS, I_MEMP, I_CMK, I_CMV, I_SRWKV, I_SSHIFT, I_SPOOL, I_SDELTA, I_SCONV, I_WIN, I_MU, I_W0, I_WUP, I_A0,
       I_AUP, I_GUP, I_KK, I_KA, I_RK, I_GNW, I_GNB, I_POOLW, I_POOLS, I_CONVW, I_ALOG, I_DTB, I_NORMW, I_WKV, I_WBR,
       I_WOUT, I_F1I, I_F1O, I_F2I, I_F2O, I_LNG, I_LNB };

__device__ __forceinline__ float bf2f(bf16_t h) { return __uint_as_float(((unsigned)h) << 16); }
__device__ __forceinline__ bf16_t f2bf(float f) { unsigned u = __float_as_uint(f); u += 0x7fffu + ((u >> 16) & 1u); return (bf16_t)(u >> 16); }
typedef float f32x2_ __attribute__((ext_vector_type(2)));
typedef __bf16 bf16x2_ __attribute__((ext_vector_type(2)));
__device__ __forceinline__ unsigned pack2(float a, float b) {
    const f32x2_ v = {a, b};
    const bf16x2_ r = __builtin_convertvector(v, bf16x2_);
    return __builtin_bit_cast(unsigned, r);
}
__device__ __forceinline__ float lo2f(unsigned u) { return __uint_as_float(u << 16); }
__device__ __forceinline__ float hi2f(unsigned u) { return __uint_as_float(u & 0xffff0000u); }
__device__ __forceinline__ float sigmoid_(float x) { return __builtin_amdgcn_rcpf(1.f + __expf(-x)); }
__device__ __forceinline__ float silu_(float x) { return x * __builtin_amdgcn_rcpf(1.f + __expf(-x)); }
__device__ __forceinline__ float softplus_(float x) { return fmaxf(x, 0.f) + __logf(1.f + __expf(-fabsf(x))); }
__device__ __forceinline__ float tanh_(float x) { return 1.f - 2.f * __builtin_amdgcn_rcpf(1.f + __expf(2.f * x)); }

__device__ __forceinline__ int tidx() { int t = threadIdx.x; asm volatile("" : "+v"(t)); return t; }
__device__ __forceinline__ float ldnt(const float* p) { return __builtin_nontemporal_load(p); }
__device__ __forceinline__ float4 ldnt4(const float* p) { const f32x4 v = __builtin_nontemporal_load((const f32x4*)p); return make_float4(v[0], v[1], v[2], v[3]); }
template <int CTRL> __device__ __forceinline__ float dpp_mov(float v) {
    return __int_as_float(__builtin_amdgcn_update_dpp(0, __float_as_int(v), CTRL, 0xf, 0xf, true));
}
__device__ __forceinline__ float red16(float v) {
    v += dpp_mov<0xB1>(v);
    v += dpp_mov<0x4E>(v);
    v += dpp_mov<0x141>(v);
    v += dpp_mov<0x140>(v);
    return v;
}
__device__ __forceinline__ float wave_sum(float v) {
    v = red16(v);
    v += __shfl_xor(v, 16);
    v += __shfl_xor(v, 32);
    return v;
}

__device__ __forceinline__ int mapcol(int kind, int n) {
    if (kind == 0) return n;
    if (kind == 1) return (n & 1) * 2048 + (n >> 1);
    if (kind == 2) { if (n < 4352) return n; if (n < 4608) return n + 8; if (n < 4616) return n - 256; return -1; }
    return n + 4616;
}
__device__ __forceinline__ void conv_job(const float* __restrict__ src, int ld, int K, bf16_t* dst, int Ndst, int kind, float* tile) {
    const int tid_ = tidx();
    const int tilesK = K >> 6, ntiles = tilesK * (Ndst >> 6);
    const int tx = tid_ & 63, ty = tid_ >> 6;
    const int tx2 = tid_ & 31, ty2 = tid_ >> 5;
    float r[16];
    int t = blockIdx.x;
    if (t < ntiles) {
        const int tk = t % tilesK, tn = t / tilesK, k0 = tk << 6, n0 = tn << 6;
        const int sc = mapcol(kind, n0 + tx);
#pragma unroll
        for (int i = 0; i < 16; ++i) r[i] = sc >= 0 ? ldnt(src + (size_t)(k0 + ty + 4 * i) * ld + sc) : 0.f;
    }
    for (; t < ntiles; t += gridDim.x) {
        const int tk = t % tilesK, tn = t / tilesK, k0 = tk << 6, n0 = tn << 6;
#pragma unroll
        for (int i = 0; i < 16; ++i) tile[(ty + 4 * i) * 65 + tx] = r[i];
        __syncthreads();
        const int tnext = t + gridDim.x;
        if (tnext < ntiles) {
            const int tk2 = tnext % tilesK, tn2 = tnext / tilesK, k2 = tk2 << 6, n2 = tn2 << 6;
            const int sc = mapcol(kind, n2 + tx);
#pragma unroll
            for (int i = 0; i < 16; ++i) r[i] = sc >= 0 ? ldnt(src + (size_t)(k2 + ty + 4 * i) * ld + sc) : 0.f;
        }
#pragma unroll
        for (int i = 0; i < 8; ++i) {
            const int nn = ty2 + 8 * i;
            *(unsigned*)(dst + (size_t)(n0 + nn) * K + k0 + 2 * tx2) = pack2(tile[(2 * tx2) * 65 + nn], tile[(2 * tx2 + 1) * 65 + nn]);
        }
        __syncthreads();
    }
}
__device__ __forceinline__ void convert_layer_weights(KP p, int l, float* tile) {
    unsigned char* ws = p->ws;
    conv_job(p->in[I_F1I] + (size_t)l * 1024 * 4096, 4096, 1024, (bf16_t*)(ws + OFF_WF1I), 4096, 1, tile);
    conv_job(p->in[I_F1O] + (size_t)l * 2048 * 1024, 1024, 2048, (bf16_t*)(ws + OFF_WF1O), 1024, 0, tile);
    conv_job(p->in[I_F2I] + (size_t)l * 1024 * 4096, 4096, 1024, (bf16_t*)(ws + OFF_WF2I), 4096, 1, tile);
    conv_job(p->in[I_F2O] + (size_t)l * 2048 * 1024, 1024, 2048, (bf16_t*)(ws + OFF_WF2O), 1024, 0, tile);
    conv_job(p->in[I_WIN] + (size_t)l * 1024 * 8712, 8712, 1024, (bf16_t*)(ws + OFF_WP), PW, 2, tile);
    conv_job(p->in[I_WIN] + (size_t)l * 1024 * 8712, 8712, 1024, (bf16_t*)(ws + OFF_WG), 4096, 3, tile);
    conv_job(p->in[I_WBR] + (size_t)l * 1792 * 1024, 1024, 1792, (bf16_t*)(ws + OFF_WB), 1024, 0, tile);
    conv_job(p->in[I_WOUT] + (size_t)l * 1024 * 1024, 1024, 1024, (bf16_t*)(ws + OFF_WO), 1024, 0, tile);
    for (int g = 0; g < 4; ++g)
        conv_job(p->in[I_POOLW] + (size_t)(l * 4 + g) * 16384, 128, 128, (bf16_t*)(ws + OFF_POOLT) + g * 16384, 128, 0, tile);
    conv_job(p->in[I_WUP] + (size_t)l * 64 * 512, 512, 64, (bf16_t*)(ws + OFF_WUP), 512, 0, tile);
    conv_job(p->in[I_AUP] + (size_t)l * 64 * 512, 512, 64, (bf16_t*)(ws + OFF_AUP), 512, 0, tile);
    conv_job(p->in[I_GUP] + (size_t)l * 128 * 512, 512, 128, (bf16_t*)(ws + OFF_GUP), 512, 0, tile);
}

__device__ __forceinline__ void phase_init(KP p, float* tile) {
    const int tid_ = tidx();
    unsigned char* ws = p->ws;
    for (int l = 0; l < 4; ++l)
        conv_job(p->in[I_WKV] + (size_t)l * 1024 * 512, 512, 1024, (bf16_t*)(ws + OFF_WKV) + (size_t)l * 512 * 1024, 512, 0, tile);
    const size_t gt = (size_t)blockIdx.x * 256 + tid_, gs = (size_t)gridDim.x * 256;
    {
        float4* X = (float4*)p->out; uint2* xb = (uint2*)(ws + OFF_XB);
        const float4* xp = (const float4*)p->in[I_XP]; const float4* xs = (const float4*)p->in[I_XS];
        const size_t np4 = (size_t)TPROMPT * 256, n4 = (size_t)NTOK * 256;
        for (size_t i0 = gt; i0 < n4; i0 += 4 * gs) {
            float4 v[4];
#pragma unroll
            for (int u = 0; u < 4; ++u) { const size_t i = i0 + u * gs; if (i < n4) v[u] = i < np4 ? ldnt4((const float*)(xp + i)) : ldnt4((const float*)(xs + (i - np4))); }
#pragma unroll
            for (int u = 0; u < 4; ++u) { const size_t i = i0 + u * gs; if (i < n4) { X[i] = v[u]; xb[i] = make_uint2(pack2(v[u].x, v[u].y), pack2(v[u].z, v[u].w)); } }
        }
    }
    {
        const float4* mp = (const float4*)p->in[I_MEMP]; uint2* mb = (uint2*)(ws + OFF_MEMB);
        for (size_t i = gt; i < (size_t)2048 * 256; i += gs) { float4 v = mp[i]; mb[i] = make_uint2(pack2(v.x, v.y), pack2(v.z, v.w)); }
    }
}

constexpr int LDT = 80;
__device__ __forceinline__ void lds_barrier() {
    asm volatile("s_waitcnt lgkmcnt(0)" ::: "memory");
    __builtin_amdgcn_s_barrier();
    asm volatile("" ::: "memory");
}
template <int NT>
__device__ __forceinline__ void gemm_compute(f32x4 (&acc)[4][NT], const bf16_t* sA, const bf16_t* sB, int wr, int wc, int fr, int fq) {
#pragma unroll
    for (int ks = 0; ks < 2; ++ks) {
        bf16x8 a[4], b[NT];
#pragma unroll
        for (int mt = 0; mt < 4; ++mt) a[mt] = *(const bf16x8*)(sA + (wr * 64 + mt * 16 + fr) * LDT + ks * 32 + fq * 8);
#pragma unroll
        for (int nt = 0; nt < NT; ++nt) b[nt] = *(const bf16x8*)(sB + (wc * 16 * NT + nt * 16 + fr) * LDT + ks * 32 + fq * 8);
        __builtin_amdgcn_s_setprio(1);
#pragma unroll
        for (int mt = 0; mt < 4; ++mt)
#pragma unroll
            for (int nt = 0; nt < NT; ++nt)
                acc[mt][nt] = __builtin_amdgcn_mfma_f32_16x16x32_bf16(b[nt], a[mt], acc[mt][nt], 0, 0, 0);
        __builtin_amdgcn_s_setprio(0);
    }
}
template <int NT>
__device__ __forceinline__ void gemm_tile(f32x4 (&acc)[4][NT], const bf16_t* A, int lda, const bf16_t* B, int ldb, int K, bf16_t* sm) {
    const int tid_ = tidx();
    bf16_t* sA = sm; bf16_t* sB = sm + 128 * LDT;
    const int tid = tid_, lane = tid & 63, wid = tid >> 6, wr = wid >> 1, wc = wid & 1;
    const int fr = lane & 15, fq = lane >> 4;
    const int lrow = tid >> 3, lkc = tid & 7;
    const bf16_t* ga = A + (size_t)lrow * lda + lkc * 8;
    const bf16_t* gb = B + (size_t)lrow * ldb + lkc * 8;
    int sbrow[NT];
#pragma unroll
    for (int i = 0; i < NT; ++i) { const int g = lrow + 32 * i, W_ = 16 * NT, rem = g % W_; sbrow[i] = (g / W_) * W_ + (rem % NT) * 16 + rem / NT; }
    u32x4 ra0[4], rb0[NT];
#pragma unroll
    for (int i = 0; i < 4; ++i) ra0[i] = *(const u32x4*)(ga + (size_t)(32 * i) * lda);
#pragma unroll
    for (int i = 0; i < NT; ++i) rb0[i] = *(const u32x4*)(gb + (size_t)(32 * i) * ldb);
    const int nk = K >> 6;
    for (int kt = 0; kt < nk; ++kt) {
        lds_barrier();
#pragma unroll
        for (int i = 0; i < 4; ++i) *(u32x4*)(sA + (lrow + 32 * i) * LDT + lkc * 8) = ra0[i];
#pragma unroll
        for (int i = 0; i < NT; ++i) *(u32x4*)(sB + sbrow[i] * LDT + lkc * 8) = rb0[i];
        lds_barrier();
        if (kt + 1 < nk) {
            ga += 64; gb += 64;
#pragma unroll
            for (int i = 0; i < 4; ++i) ra0[i] = *(const u32x4*)(ga + (size_t)(32 * i) * lda);
#pragma unroll
            for (int i = 0; i < NT; ++i) rb0[i] = *(const u32x4*)(gb + (size_t)(32 * i) * ldb);
        }
        __builtin_amdgcn_sched_barrier(0);
        gemm_compute<NT>(acc, sA, sB, wr, wc, fr, fq);
        __builtin_amdgcn_sched_barrier(0);
    }
}
template <int NT> __device__ __forceinline__ void zero_acc(f32x4 (&acc)[4][NT]) {
#pragma unroll
    for (int mt = 0; mt < 4; ++mt)
#pragma unroll
        for (int nt = 0; nt < NT; ++nt) acc[mt][nt] = (f32x4){0.f, 0.f, 0.f, 0.f};
}

template <int NT>
__device__ __forceinline__ void gather_cols(const f32x4 (&acc)[4][NT], int mt, float (&v)[4 * NT]) {
#pragma unroll
    for (int e = 0; e < 4 * NT; ++e) v[e] = acc[mt][e % NT][e / NT];
}
__device__ __forceinline__ void phase_ffn_in(const bf16_t* xb, const bf16_t* W, bf16_t* H, bf16_t* sm) {
    const int tid_ = tidx();
    const int lane = tid_ & 63, wid = tid_ >> 6, wr = wid >> 1, wc = wid & 1, fr = lane & 15, fq = lane >> 4;
    for (int t = blockIdx.x; t < 136 * 32; t += gridDim.x) {
        const int tm = t >> 5, tn = t & 31;
        f32x4 acc[4][4]; zero_acc<4>(acc);
        gemm_tile<4>(acc, xb + (size_t)tm * 128 * 1024, 1024, W + (size_t)tn * 128 * 1024, 1024, 1024, sm);
#pragma unroll
        for (int mt = 0; mt < 4; ++mt) {
            const int row = tm * 128 + wr * 64 + mt * 16 + fr;
            const int hc = tn * 64 + wc * 32 + fq * 8;
            float v[16]; gather_cols<4>(acc, mt, v);
            u32x4 o;
#pragma unroll
            for (int q = 0; q < 4; ++q) o[q] = pack2(silu_(v[4 * q]) * v[4 * q + 1], silu_(v[4 * q + 2]) * v[4 * q + 3]);
            *(u32x4*)(H + (size_t)row * 2048 + hc) = o;
        }
    }
}
template <int NT>
__device__ __forceinline__ void resid_tile(int tm, int col0, const bf16_t* A, int lda, int K, const bf16_t* W, const float* X, float* Y, float scale, bf16_t* sm) {
    const int tid_ = tidx();
    const int lane = tid_ & 63, wid = tid_ >> 6, wr = wid >> 1, wc = wid & 1, fr = lane & 15, fq = lane >> 4;
    f32x4 acc[4][NT]; zero_acc<NT>(acc);
    gemm_tile<NT>(acc, A + (size_t)tm * 128 * lda, lda, W + (size_t)col0 * K, K, K, sm);
#pragma unroll
    for (int mt = 0; mt < 4; ++mt) {
        const int row = tm * 128 + wr * 64 + mt * 16 + fr;
        const int cbase = col0 + wc * 16 * NT + fq * 4 * NT;
        const size_t o = (size_t)row * 1024 + cbase;
        float v[4 * NT]; gather_cols<NT>(acc, mt, v);
        float4 xv[NT];
#pragma unroll
        for (int q = 0; q < NT; ++q) xv[q] = *(const float4*)(X + o + 4 * q);
#pragma unroll
        for (int q = 0; q < NT; ++q)
            *(float4*)(Y + o + 4 * q) = make_float4(ALPHA * xv[q].x + scale * v[4 * q], ALPHA * xv[q].y + scale * v[4 * q + 1],
                                                    ALPHA * xv[q].z + scale * v[4 * q + 2], ALPHA * xv[q].w + scale * v[4 * q + 3]);
    }
}
__device__ __forceinline__ void phase_gemm_resid(const bf16_t* A, int lda, int K, const bf16_t* W, const float* X, float* Y, float scale, bf16_t* sm) {
    const int G = gridDim.x, NTILES = 136 * 8;
    const int nfull = (NTILES / G) * G;
    for (int t = blockIdx.x; t < nfull; t += G) resid_tile<4>(t >> 3, (t & 7) * 128, A, lda, K, W, X, Y, scale, sm);
    for (int u = blockIdx.x; u < 2 * (NTILES - nfull); u += G) {
        const int t = nfull + (u >> 1);
        resid_tile<2>(t >> 3, (t & 7) * 128 + (u & 1) * 64, A, lda, K, W, X, Y, scale, sm);
    }
}
__device__ __forceinline__ void phase_proj(const bf16_t* xb, const bf16_t* W, bf16_t* P, bf16_t* sm) {
    const int tid_ = tidx();
    const int lane = tid_ & 63, wid = tid_ >> 6, wr = wid >> 1, wc = wid & 1, fr = lane & 15, fq = lane >> 4;
    for (int t = blockIdx.x; t < 136 * 37; t += gridDim.x) {
        const int tm = t / 37, tn = t % 37;
        f32x4 acc[4][4]; zero_acc<4>(acc);
        gemm_tile<4>(acc, xb + (size_t)tm * 128 * 1024, 1024, W + (size_t)tn * 128 * 1024, 1024, 1024, sm);
#pragma unroll
        for (int mt = 0; mt < 4; ++mt) {
            const int row = tm * 128 + wr * 64 + mt * 16 + fr;
            const int cbase = tn * 128 + wc * 64 + fq * 16;
            float v[16]; gather_cols<4>(acc, mt, v);
            u32x4 o0, o1;
#pragma unroll
            for (int q = 0; q < 4; ++q) { o0[q] = pack2(v[2 * q], v[2 * q + 1]); o1[q] = pack2(v[8 + 2 * q], v[8 + 2 * q + 1]); }
            *(u32x4*)(P + (size_t)row * PW + cbase) = o0;
            *(u32x4*)(P + (size_t)row * PW + cbase + 8) = o1;
        }
    }
}
__device__ __forceinline__ void phase_memkv(KP p, bf16_t* sm) {
    const int tid_ = tidx();
    const int lane = tid_ & 63, wid = tid_ >> 6, wr = wid >> 1, wc = wid & 1, fr = lane & 15, fq = lane >> 4;
    const bf16_t* memb = (const bf16_t*)(p->ws + OFF_MEMB);
    const bf16_t* wkv = (const bf16_t*)(p->ws + OFF_WKV);
    bf16_t* Kp = (bf16_t*)(p->ws + OFF_KP); bf16_t* Vtp = (bf16_t*)(p->ws + OFF_VTP);
    for (int t = blockIdx.x; t < 4 * 16 * 4; t += gridDim.x) {
        const int l = t >> 6, tm = (t >> 2) & 15, tn = t & 3;
        f32x4 acc[4][4]; zero_acc<4>(acc);
        gemm_tile<4>(acc, memb + (size_t)tm * 128 * 1024, 1024, wkv + ((size_t)l * 512 + tn * 128) * 1024, 1024, 1024, sm);
#pragma unroll
        for (int mt = 0; mt < 4; ++mt) {
            const int row = tm * 128 + wr * 64 + mt * 16 + fr;
            const int cbase = tn * 128 + wc * 64 + fq * 16;
            float v[16]; gather_cols<4>(acc, mt, v);
            const int b = row >> 8, key = row & 255;
#pragma unroll
            for (int e = 0; e < 16; ++e) {
                const int col = cbase + e;
                if (col < 256) {
                    p->out[O_PMK + ((size_t)l * 2048 + row) * 256 + col] = v[e];
                    const int h = col >> 6, d = col & 63;
                    Kp[((size_t)((l * 8 + b) * 4 + h)) * 16384 + key * 64 + d] = f2bf(v[e]);
                } else {
                    const int c2 = col - 256;
                    p->out[O_PMV + ((size_t)l * 2048 + row) * 256 + c2] = v[e];
                    const int h = c2 >> 6, d = c2 & 63;
                    Vtp[((size_t)((l * 8 + b) * 4 + h)) * 16384 + d * 256 + key] = f2bf(v[e]);
                }
            }
        }
    }
}
__device__ __forceinline__ void gate_tile(int t, const bf16_t* xb, const bf16_t* Wg, bf16_t* G, bf16_t* sm) {
    const int tid_ = tidx();
    const int lane = tid_ & 63, wid = tid_ >> 6, wr = wid >> 1, wc = wid & 1, fr = lane & 15, fq = lane >> 4;
    const int tm = t >> 5, tn = t & 31;
    f32x4 acc[4][4]; zero_acc<4>(acc);
    gemm_tile<4>(acc, xb + (size_t)tm * 128 * 1024, 1024, Wg + (size_t)tn * 128 * 1024, 1024, 1024, sm);
#pragma unroll
    for (int mt = 0; mt < 4; ++mt) {
        const int row = tm * 128 + wr * 64 + mt * 16 + fr;
        const int cbase = tn * 128 + wc * 64 + fq * 16;
        float v[16]; gather_cols<4>(acc, mt, v);
        u32x4 o0, o1;
#pragma unroll
        for (int q = 0; q < 4; ++q) {
            o0[q] = pack2(sigmoid_(v[2 * q]), sigmoid_(v[2 * q + 1]));
            o1[q] = pack2(sigmoid_(v[8 + 2 * q]), sigmoid_(v[8 + 2 * q + 1]));
        }
        *(u32x4*)(G + (size_t)row * 4096 + cbase) = o0;
        *(u32x4*)(G + (size_t)row * 4096 + cbase + 8) = o1;
    }
}
__device__ __forceinline__ void phase_merge(const bf16_t* G, const bf16_t* BO, const bf16_t* Wb, bf16_t* M, bf16_t* sm) {
    const int tid_ = tidx();
    const int lane = tid_ & 63, wid = tid_ >> 6, wr = wid >> 1, wc = wid & 1, fr = lane & 15, fq = lane >> 4;
    for (int t = blockIdx.x; t < 136 * 16; t += gridDim.x) {
        const int tm = t >> 4, tn = t & 15;
        const int cbase = tn * 64 + wc * 32 + fq * 8;
        f32x4 accm[4][2]; zero_acc<2>(accm);
#pragma unroll 1
        for (int i = 0; i < 4; ++i) {
            f32x4 accb[4][2]; zero_acc<2>(accb);
            const int koff = i * 512, kk = i < 3 ? 512 : 256;
            gemm_tile<2>(accb, BO + (size_t)tm * 128 * 1792 + koff, 1792, Wb + (size_t)tn * 64 * 1792 + koff, 1792, kk, sm);
#pragma unroll
            for (int mt = 0; mt < 4; ++mt) {
                const int row = tm * 128 + wr * 64 + mt * 16 + fr;
                const u32x4 gu = *(const u32x4*)(G + (size_t)row * 4096 + i * 1024 + cbase);
#pragma unroll
                for (int e = 0; e < 8; ++e) {
                    const float gv = (e & 1) ? hi2f(gu[e >> 1]) : lo2f(gu[e >> 1]);
                    accm[mt][e % 2][e / 2] += gv * accb[mt][e % 2][e / 2];
                }
            }
        }
#pragma unroll
        for (int mt = 0; mt < 4; ++mt) {
            const int row = tm * 128 + wr * 64 + mt * 16 + fr;
            float v[8]; gather_cols<2>(accm, mt, v);
            u32x4 o;
#pragma unroll
            for (int q = 0; q < 4; ++q) o[q] = pack2(v[2 * q], v[2 * q + 1]);
            *(u32x4*)(M + (size_t)row * 1024 + cbase) = o;
        }
    }
}
__device__ __forceinline__ void pool_gemm_tile(int t, const bf16_t* pooled, const bf16_t* PoolT, const float* pscale, bf16_t* BO, bf16_t* sm) {
    const int tid_ = tidx();
    const int lane = tid_ & 63, wid = tid_ >> 6, wr = wid >> 1, wc = wid & 1, fr = lane & 15, fq = lane >> 4;
    const int tm = t >> 2, g = t & 3;
    f32x4 acc[4][4]; zero_acc<4>(acc);
    gemm_tile<4>(acc, pooled + (size_t)tm * 128 * 512 + g * 128, 512, PoolT + g * 16384, 128, 128, sm);
    const int cbase = g * 128 + wc * 64 + fq * 16;
    float ps[16];
#pragma unroll
    for (int q = 0; q < 4; ++q) { const float4 s4 = *(const float4*)(pscale + cbase + 4 * q); ps[4 * q] = s4.x; ps[4 * q + 1] = s4.y; ps[4 * q + 2] = s4.z; ps[4 * q + 3] = s4.w; }
#pragma unroll
    for (int mt = 0; mt < 4; ++mt) {
        const int row = tm * 128 + wr * 64 + mt * 16 + fr;
        float v[16]; gather_cols<4>(acc, mt, v);
        u32x4 o0, o1;
#pragma unroll
        for (int q = 0; q < 4; ++q) {
            o0[q] = pack2(v[2 * q] * ps[2 * q], v[2 * q + 1] * ps[2 * q + 1]);
            o1[q] = pack2(v[8 + 2 * q] * ps[8 + 2 * q], v[8 + 2 * q + 1] * ps[8 + 2 * q + 1]);
        }
        *(u32x4*)(BO + (size_t)row * 1792 + 512 + cbase) = o0;
        *(u32x4*)(BO + (size_t)row * 1792 + 512 + cbase + 8) = o1;
    }
}

__device__ __forceinline__ void phase_ln(const float* Y, float* X, bf16_t* xb, const float* g, const float* b) {
    const int tid_ = tidx();
    const int lane = tid_ & 63, wid = tid_ >> 6;
    const int stride = gridDim.x * 4;
    int row = blockIdx.x * 4 + wid;
    float4 v[4], vn[4];
    if (row < NTOK) {
#pragma unroll
        for (int i = 0; i < 4; ++i) v[i] = ldnt4(Y + (size_t)row * 1024 + (lane + 64 * i) * 4);
    }
    float4 gg[4], bb[4];
#pragma unroll
    for (int i = 0; i < 4; ++i) { gg[i] = ((const float4*)g)[lane + 64 * i]; bb[i] = ((const float4*)b)[lane + 64 * i]; }
    for (; row < NTOK; row += stride) {
        const int nrow = row + stride;
        if (nrow < NTOK) {
#pragma unroll
            for (int i = 0; i < 4; ++i) vn[i] = ldnt4(Y + (size_t)nrow * 1024 + (lane + 64 * i) * 4);
        }
        float s = 0.f;
#pragma unroll
        for (int i = 0; i < 4; ++i) s += v[i].x + v[i].y + v[i].z + v[i].w;
        const float mean = wave_sum(s) * (1.f / 1024.f);
        float q = 0.f;
#pragma unroll
        for (int i = 0; i < 4; ++i) {
            v[i].x -= mean; v[i].y -= mean; v[i].z -= mean; v[i].w -= mean;
            q += v[i].x * v[i].x + v[i].y * v[i].y + v[i].z * v[i].z + v[i].w * v[i].w;
        }
        const float rstd = rsqrtf(wave_sum(q) * (1.f / 1024.f) + 1e-5f);
#pragma unroll
        for (int i = 0; i < 4; ++i) {
            const int c4 = lane + 64 * i;
            float4 o;
            o.x = v[i].x * rstd * gg[i].x + bb[i].x; o.y = v[i].y * rstd * gg[i].y + bb[i].y;
            o.z = v[i].z * rstd * gg[i].z + bb[i].z; o.w = v[i].w * rstd * gg[i].w + bb[i].w;
            ((float4*)(X + (size_t)row * 1024))[c4] = o;
            ((uint2*)(xb + (size_t)row * 1024))[c4] = make_uint2(pack2(o.x, o.y), pack2(o.z, o.w));
        }
#pragma unroll
        for (int i = 0; i < 4; ++i) v[i] = vn[i];
    }
}

__device__ __forceinline__ void conv_sample_kv(KP p, int l) {
    const int tid_ = tidx();
    const size_t gt = (size_t)blockIdx.x * 256 + tid_, gs = (size_t)gridDim.x * 256;
    const float* ck = p->in[I_CMK] + (size_t)l * 128 * 256 * 256;
    const float* cv = p->in[I_CMV] + (size_t)l * 128 * 256 * 256;
    bf16_t* Ks = (bf16_t*)(p->ws + OFF_KS); bf16_t* Vts = (bf16_t*)(p->ws + OFF_VTS);
    for (size_t i0 = gt; i0 < (size_t)128 * 256 * 64; i0 += 4 * gs) {
        float4 v[4];
#pragma unroll
        for (int u = 0; u < 4; ++u) { const size_t i = i0 + u * gs; if (i < (size_t)128 * 256 * 64) v[u] = ldnt4(ck + i * 4); }
#pragma unroll
        for (int u = 0; u < 4; ++u) {
            const size_t i = i0 + u * gs;
            if (i < (size_t)128 * 256 * 64) {
                const int d4 = i & 15, h = (i >> 4) & 3, key = (i >> 6) & 255, b = (int)(i >> 14);
                *(uint2*)(Ks + ((size_t)(b * 4 + h) * 256 + key) * 64 + d4 * 4) = make_uint2(pack2(v[u].x, v[u].y), pack2(v[u].z, v[u].w));
            }
        }
    }
    for (size_t i0 = gt; i0 < (size_t)128 * 64 * 256; i0 += 4 * gs) {
        float v[4][4];
#pragma unroll
        for (int u = 0; u < 4; ++u) {
            const size_t i = i0 + u * gs;
            if (i < (size_t)128 * 64 * 256) {
                const int d = i & 63, h = (i >> 6) & 3, kq = (i >> 8) & 63, b = (int)(i >> 14);
#pragma unroll
                for (int j = 0; j < 4; ++j) v[u][j] = ldnt(cv + ((size_t)(b * 256 + kq * 4 + j) * 4 + h) * 64 + d);
            }
        }
#pragma unroll
        for (int u = 0; u < 4; ++u) {
            const size_t i = i0 + u * gs;
            if (i < (size_t)128 * 64 * 256) {
                const int d = i & 63, h = (i >> 6) & 3, kq = (i >> 8) & 63, b = (int)(i >> 14);
                *(uint2*)(Vts + ((size_t)(b * 4 + h) * 64 + d) * 256 + kq * 4) = make_uint2(pack2(v[u][0], v[u][1]), pack2(v[u][2], v[u][3]));
            }
        }
    }
}

__device__ __forceinline__ void attn_task(const bf16_t* P, int rowbase, int nvalid, const bf16_t* Kb, const bf16_t* Vt, bf16_t* BO, int h) {
    const int tid_ = tidx();
    const int lane = tid_ & 63, fr = lane & 15, fq = lane >> 4;
    const int qrow = rowbase + (fr < nvalid ? fr : nvalid - 1);
    const bf16_t* qp = P + (size_t)qrow * PW + PM + h * 64 + fq * 8;
    const bf16x8 qb0 = *(const bf16x8*)qp, qb1 = *(const bf16x8*)(qp + 32);
    f32x4 s[16];
#pragma unroll
    for (int mt = 0; mt < 16; ++mt) {
        const bf16_t* kp = Kb + (mt * 16 + fr) * 64 + fq * 8;
        const bf16x8 a0 = *(const bf16x8*)kp, a1 = *(const bf16x8*)(kp + 32);
        f32x4 z = {0.f, 0.f, 0.f, 0.f};
        z = __builtin_amdgcn_mfma_f32_16x16x32_bf16(a0, qb0, z, 0, 0, 0);
        s[mt] = __builtin_amdgcn_mfma_f32_16x16x32_bf16(a1, qb1, z, 0, 0, 0);
    }
    float mx = -3.0e38f;
#pragma unroll
    for (int mt = 0; mt < 16; ++mt)
#pragma unroll
        for (int j = 0; j < 4; ++j) { s[mt][j] *= 0.125f; mx = fmaxf(mx, s[mt][j]); }
    mx = fmaxf(mx, __shfl_xor(mx, 16)); mx = fmaxf(mx, __shfl_xor(mx, 32));
    float sum = 0.f;
#pragma unroll
    for (int mt = 0; mt < 16; ++mt)
#pragma unroll
        for (int j = 0; j < 4; ++j) { const float e = __expf(s[mt][j] - mx); s[mt][j] = e; sum += e; }
    sum += __shfl_xor(sum, 16); sum += __shfl_xor(sum, 32);
    f32x4 o[4];
#pragma unroll
    for (int dt = 0; dt < 4; ++dt) o[dt] = (f32x4){0.f, 0.f, 0.f, 0.f};
#pragma unroll
    for (int st = 0; st < 8; ++st) {
        union { bf16x8 v; unsigned u[4]; } pb;
        pb.u[0] = pack2(s[2 * st][0], s[2 * st][1]); pb.u[1] = pack2(s[2 * st][2], s[2 * st][3]);
        pb.u[2] = pack2(s[2 * st + 1][0], s[2 * st + 1][1]); pb.u[3] = pack2(s[2 * st + 1][2], s[2 * st + 1][3]);
#pragma unroll
        for (int dt = 0; dt < 4; ++dt) {
            const bf16_t* vp = Vt + (dt * 16 + fr) * 256 + st * 32 + fq * 4;
            union { bf16x8 v; uint2 u[2]; } av;
            av.u[0] = *(const uint2*)vp; av.u[1] = *(const uint2*)(vp + 16);
            o[dt] = __builtin_amdgcn_mfma_f32_16x16x32_bf16(av.v, pb.v, o[dt], 0, 0, 0);
        }
    }
    const float inv = 1.f / sum;
    if (fr < nvalid) {
#pragma unroll
        for (int dt = 0; dt < 4; ++dt)
            *(uint2*)(BO + (size_t)(rowbase + fr) * 1792 + 1536 + h * 64 + dt * 16 + fq * 4) =
                make_uint2(pack2(o[dt][0] * inv, o[dt][1] * inv), pack2(o[dt][2] * inv, o[dt][3] * inv));
    }
}

__device__ __forceinline__ void rwkv_prep_task(KP p, int l, int tile, int hg, bf16_t* sAp) {
    const int tid_ = tidx();
    const int tid = tid_, lane = tid & 63, wid = tid >> 6, fr = lane & 15, fq = lane >> 4;
    const bf16_t* P = (const bf16_t*)(p->ws + OFF_P);
    const float* mu = p->in[I_MU] + l * 1792;
    const float* shs = p->in[I_SSHIFT] + (size_t)l * 128 * 1792;
    const int row0 = tile * 16;
    const bool samp = row0 >= TPROMPT;
    const int sb0 = samp ? (row0 - TPROMPT) >> 3 : 0;
    {
        const int c = tid, col = 1536 + c;
        const float m = mu[col];
        float cur[17];
#pragma unroll
        for (int i = 0; i < 17; ++i) cur[i] = bf2f(P[(size_t)(row0 + i > 0 ? row0 + i - 1 : 0) * PW + col]);
        const float sh0 = shs[(size_t)sb0 * 1792 + col], sh1 = shs[(size_t)(sb0 + 1 < 128 ? sb0 + 1 : 127) * 1792 + col];
#pragma unroll
        for (int i = 0; i < 16; ++i) {
            float pv = cur[i];
            if (!samp) { if (((row0 + i) & 2047) == 0) pv = 0.f; }
            else { if (i == 0) pv = sh0; if (i == 8) pv = sh1; }
            const float xm = cur[i + 1] + (pv - cur[i + 1]) * m;
            const float val = c < 64 ? tanh_(xm) : (c < 128 ? xm : sigmoid_(xm));
            sAp[i * 264 + c] = f2bf(val);
        }
    }
    __syncthreads();
    const int h = hg * 4 + wid;
    bf16x8 af[8];
#pragma unroll
    for (int ks = 0; ks < 8; ++ks) af[ks] = *(const bf16x8*)(sAp + fr * 264 + ks * 32 + fq * 8);
    const bf16_t* WupT = (const bf16_t*)(p->ws + OFF_WUP);
    const bf16_t* AupT = (const bf16_t*)(p->ws + OFF_AUP);
    const bf16_t* GupT = (const bf16_t*)(p->ws + OFF_GUP);
    f32x4 az[4], aa[4], ag[4];
#pragma unroll
    for (int nt = 0; nt < 4; ++nt) {
        const int n = h * 64 + fr * 4 + nt;
        f32x4 z = {0.f, 0.f, 0.f, 0.f};
        z = __builtin_amdgcn_mfma_f32_16x16x32_bf16(*(const bf16x8*)(WupT + n * 64 + fq * 8), af[0], z, 0, 0, 0);
        z = __builtin_amdgcn_mfma_f32_16x16x32_bf16(*(const bf16x8*)(WupT + n * 64 + 32 + fq * 8), af[1], z, 0, 0, 0);
        az[nt] = z;
        f32x4 a = {0.f, 0.f, 0.f, 0.f};
        a = __builtin_amdgcn_mfma_f32_16x16x32_bf16(*(const bf16x8*)(AupT + n * 64 + fq * 8), af[2], a, 0, 0, 0);
        a = __builtin_amdgcn_mfma_f32_16x16x32_bf16(*(const bf16x8*)(AupT + n * 64 + 32 + fq * 8), af[3], a, 0, 0, 0);
        aa[nt] = a;
        f32x4 g = {0.f, 0.f, 0.f, 0.f};
#pragma unroll
        for (int ks = 0; ks < 4; ++ks)
            g = __builtin_amdgcn_mfma_f32_16x16x32_bf16(*(const bf16x8*)(GupT + n * 128 + ks * 32 + fq * 8), af[4 + ks], g, 0, 0, 0);
        ag[nt] = g;
    }
    float* Rw = (float*)(p->ws + OFF_RW);
    bf16_t* Rkk = (bf16_t*)(p->ws + OFF_RKK); bf16_t* Rka = (bf16_t*)(p->ws + OFF_RKA); bf16_t* Rkp = (bf16_t*)(p->ws + OFF_RKP);
    bf16_t* Rr = (bf16_t*)(p->ws + OFF_RR); bf16_t* Rv = (bf16_t*)(p->ws + OFF_RV); bf16_t* Rg = (bf16_t*)(p->ws + OFF_RG);
    float* Rc = (float*)(p->ws + OFF_RC);
    const int R = row0 + fr;
    bool first; int sb = 0;
    if (!samp) first = (R & 2047) == 0; else { const int rs = R - TPROMPT; first = (rs & 7) == 0; sb = rs >> 3; }
    const int cb = h * 64 + fq * 16;
    float x3[3][16];
#pragma unroll
    for (int q = 0; q < 3; ++q) {
        const int col = q * 512 + cb;
        const u32x4 c0 = *(const u32x4*)(P + (size_t)R * PW + col), c1 = *(const u32x4*)(P + (size_t)R * PW + col + 8);
        const u32x4 p0 = *(const u32x4*)(P + (size_t)(R > 0 ? R - 1 : 0) * PW + col), p1 = *(const u32x4*)(P + (size_t)(R > 0 ? R - 1 : 0) * PW + col + 8);
#pragma unroll
        for (int e4 = 0; e4 < 4; ++e4) {
            const float4 su = *(const float4*)(shs + (size_t)sb * 1792 + col + e4 * 4);
            const float4 m4 = *(const float4*)(mu + col + e4 * 4);
            const float sv[4] = {su.x, su.y, su.z, su.w}, mm[4] = {m4.x, m4.y, m4.z, m4.w};
#pragma unroll
            for (int k = 0; k < 4; ++k) {
                const int e = e4 * 4 + k;
                const unsigned cu = e < 8 ? c0[e >> 1] : c1[(e - 8) >> 1], pu = e < 8 ? p0[e >> 1] : p1[(e - 8) >> 1];
                const float cv = (e & 1) ? hi2f(cu) : lo2f(cu), pp = (e & 1) ? hi2f(pu) : lo2f(pu);
                const float prev = first ? (samp ? sv[k] : 0.f) : pp;
                x3[q][e] = cv + (prev - cv) * mm[k];
            }
        }
    }
    float wd[16], kp[16], kkv[16], av[16], gv[16];
    float ss = 0.f, bon = 0.f;
#pragma unroll
    for (int e4 = 0; e4 < 4; ++e4) {
        const float4 w04 = *(const float4*)(p->in[I_W0] + l * 512 + cb + e4 * 4), a04 = *(const float4*)(p->in[I_A0] + l * 512 + cb + e4 * 4);
        const float4 kk4 = *(const float4*)(p->in[I_KK] + l * 512 + cb + e4 * 4), ka4 = *(const float4*)(p->in[I_KA] + l * 512 + cb + e4 * 4);
        const float4 rk4 = *(const float4*)(p->in[I_RK] + l * 512 + cb + e4 * 4);
        const float w0v[4] = {w04.x, w04.y, w04.z, w04.w}, a0v[4] = {a04.x, a04.y, a04.z, a04.w};
        const float kkp[4] = {kk4.x, kk4.y, kk4.z, kk4.w}, kap[4] = {ka4.x, ka4.y, ka4.z, ka4.w}, rkp[4] = {rk4.x, rk4.y, rk4.z, rk4.w};
#pragma unroll
        for (int k = 0; k < 4; ++k) {
            const int e = e4 * 4 + k;
            const float z = w0v[k] + az[k][e4];
            wd[e] = __expf(-__expf(-softplus_(-z) - 0.5f));
            const float a = sigmoid_(a0v[k] + aa[k][e4]);
            const float kx = x3[1][e];
            kkv[e] = kx * kkp[k];
            kp[e] = kx * (1.f + (a - 1.f) * kap[k]);
            av[e] = a; gv[e] = ag[k][e4];
            ss += kkv[e] * kkv[e];
            bon += x3[0][e] * kp[e] * rkp[k];
        }
    }
    ss += __shfl_xor(ss, 16); ss += __shfl_xor(ss, 32);
    bon += __shfl_xor(bon, 16); bon += __shfl_xor(bon, 32);
    const float inv = rsqrtf(ss + 1e-12f);
    const size_t o = (size_t)R * 512 + cb;
#pragma unroll
    for (int e4 = 0; e4 < 4; ++e4) *(float4*)(Rw + o + e4 * 4) = make_float4(wd[e4 * 4], wd[e4 * 4 + 1], wd[e4 * 4 + 2], wd[e4 * 4 + 3]);
#pragma unroll
    for (int hf = 0; hf < 2; ++hf) {
        u32x4 vkk, vka, vkp, vr, vv, vg;
#pragma unroll
        for (int k = 0; k < 4; ++k) {
            const int e = hf * 8 + k * 2;
            const float k0 = kkv[e] * inv, k1 = kkv[e + 1] * inv;
            vkk[k] = pack2(k0, k1); vka[k] = pack2(k0 * av[e], k1 * av[e + 1]); vkp[k] = pack2(kp[e], kp[e + 1]);
            vr[k] = pack2(x3[0][e], x3[0][e + 1]); vv[k] = pack2(x3[2][e], x3[2][e + 1]); vg[k] = pack2(gv[e], gv[e + 1]);
        }
        *(u32x4*)(Rkk + o + hf * 8) = vkk; *(u32x4*)(Rka + o + hf * 8) = vka; *(u32x4*)(Rkp + o + hf * 8) = vkp;
        *(u32x4*)(Rr + o + hf * 8) = vr; *(u32x4*)(Rv + o + hf * 8) = vv; *(u32x4*)(Rg + o + hf * 8) = vg;
    }
    if (fq == 0) Rc[(size_t)R * 8 + h] = bon;
    __syncthreads();
}

__device__ __forceinline__ void delta_prep_row(KP p, int l, int R) {
    const int tid_ = tidx();
    const int lane = tid_ & 63;
    const bf16_t* P = (const bf16_t*)(p->ws + OFF_P);
    bf16_t* Dq = (bf16_t*)(p->ws + OFF_DQ); bf16_t* Dk = (bf16_t*)(p->ws + OFF_DK); bf16_t* Dv = (bf16_t*)(p->ws + OFF_DV);
    float* Dsc = (float*)(p->ws + OFF_DSC);
    int t, seq0, sb = 0; bool samp = R >= TPROMPT;
    if (!samp) { t = R & 2047; seq0 = R - t; } else { const int rs = R - TPROMPT; t = rs & 7; sb = rs >> 3; seq0 = R - t; }
    const float* cbuf = p->in[I_SCONV] + (size_t)(l * 128 + sb) * 3 * 1536;
    const float* cw = p->in[I_CONVW] + (size_t)l * 4 * 1536;
    const bool edge = samp || t < 3;
#pragma unroll 1
    for (int sg = 0; sg < 3; ++sg) {
        float va[4][2];
        if (!edge) {
#pragma unroll
            for (int s4 = 0; s4 < 4; ++s4) {
                const int c = (sg * 4 + s4) * 128 + lane * 2;
                unsigned u[4]; float2 w[4];
#pragma unroll
                for (int j = 0; j < 4; ++j) {
                    u[j] = *(const unsigned*)(P + (size_t)(R - 3 + j) * PW + PC + c);
                    w[j] = *(const float2*)(cw + (size_t)j * 1536 + c);
                }
                float a0 = 0.f, a1 = 0.f;
#pragma unroll
                for (int j = 0; j < 4; ++j) { a0 += lo2f(u[j]) * w[j].x; a1 += hi2f(u[j]) * w[j].y; }
                va[s4][0] = silu_(a0); va[s4][1] = silu_(a1);
            }
        } else {
#pragma unroll
            for (int s4 = 0; s4 < 4; ++s4) {
                const int c = (sg * 4 + s4) * 128 + lane * 2;
                unsigned u[4]; float2 w[4], f[4];
#pragma unroll
                for (int j = 0; j < 4; ++j) {
                    const int tau = t - 3 + j;
                    u[j] = *(const unsigned*)(P + (size_t)(seq0 + (tau >= 0 ? tau : 0)) * PW + PC + c);
                    int bi = 3 + tau; bi = bi < 0 ? 0 : (bi > 2 ? 2 : bi);
                    f[j] = *(const float2*)(cbuf + (size_t)bi * 1536 + c);
                    w[j] = *(const float2*)(cw + (size_t)j * 1536 + c);
                }
                float a0 = 0.f, a1 = 0.f;
#pragma unroll
                for (int j = 0; j < 4; ++j) {
                    const int tau = t - 3 + j;
                    const float x0 = tau >= 0 ? lo2f(u[j]) : (samp ? f[j].x : 0.f);
                    const float x1 = tau >= 0 ? hi2f(u[j]) : (samp ? f[j].y : 0.f);
                    a0 += x0 * w[j].x; a1 += x1 * w[j].y;
                }
                va[s4][0] = silu_(a0); va[s4][1] = silu_(a1);
            }
        }
        bf16_t* dst = sg == 0 ? Dq : (sg == 1 ? Dk : Dv);
#pragma unroll
        for (int s4 = 0; s4 < 4; ++s4) {
            float a0 = va[s4][0], a1 = va[s4][1];
            if (sg < 2) {
                const float ss = wave_sum(a0 * a0 + a1 * a1);
                float sc = rsqrtf(ss + 1e-12f);
                if (sg == 0) sc *= 0.08838834764831845f;
                a0 *= sc; a1 *= sc;
            }
            *(unsigned*)(dst + (size_t)R * 512 + s4 * 128 + lane * 2) = pack2(a0, a1);
        }
    }
    {
        bf16_t* SZ = (bf16_t*)(p->ws + OFF_SZ);
        unsigned zu[4];
#pragma unroll
        for (int hh = 0; hh < 4; ++hh) zu[hh] = *(const unsigned*)(P + (size_t)R * PW + PC + 1536 + hh * 128 + lane * 2);
#pragma unroll
        for (int hh = 0; hh < 4; ++hh) *(unsigned*)(SZ + (size_t)R * 512 + hh * 128 + lane * 2) = pack2(silu_(lo2f(zu[hh])), silu_(hi2f(zu[hh])));
    }
    if (lane < 4) {
        const float bb = bf2f(P[(size_t)R * PW + PBA + lane]);
        const float aa = bf2f(P[(size_t)R * PW + PBA + 4 + lane]);
        const float beta = sigmoid_(bb);
        const float g = -__expf(p->in[I_ALOG][l * 4 + lane]) * softplus_(aa + p->in[I_DTB][l * 4 + lane]);
        Dsc[((size_t)R * 4 + lane) * 2] = beta;
        Dsc[((size_t)R * 4 + lane) * 2 + 1] = __expf(g);
    }
}

__device__ __forceinline__ void delta_prep_quad(KP p, int l, int R0) {
    const int tid_ = tidx();
    const int lane = tid_ & 63;
    const bf16_t* P = (const bf16_t*)(p->ws + OFF_P);
    bf16_t* Dq = (bf16_t*)(p->ws + OFF_DQ); bf16_t* Dk = (bf16_t*)(p->ws + OFF_DK); bf16_t* Dv = (bf16_t*)(p->ws + OFF_DV);
    float* Dsc = (float*)(p->ws + OFF_DSC);
    bf16_t* SZ = (bf16_t*)(p->ws + OFF_SZ);
    const float* cw = p->in[I_CONVW] + (size_t)l * 4 * 1536;
#pragma unroll 1
    for (int sg = 0; sg < 3; ++sg) {
        unsigned u[4][7]; float2 w[4][4];
#pragma unroll
        for (int s4 = 0; s4 < 4; ++s4) {
            const int c = (sg * 4 + s4) * 128 + lane * 2;
#pragma unroll
            for (int r = 0; r < 7; ++r) u[s4][r] = *(const unsigned*)(P + (size_t)(R0 - 3 + r) * PW + PC + c);
#pragma unroll
            for (int j = 0; j < 4; ++j) w[s4][j] = *(const float2*)(cw + (size_t)j * 1536 + c);
        }
        float v0[4][4], v1[4][4];
#pragma unroll
        for (int tk = 0; tk < 4; ++tk)
#pragma unroll
            for (int s4 = 0; s4 < 4; ++s4) {
                float a0 = 0.f, a1 = 0.f;
#pragma unroll
                for (int j = 0; j < 4; ++j) { a0 += lo2f(u[s4][tk + j]) * w[s4][j].x; a1 += hi2f(u[s4][tk + j]) * w[s4][j].y; }
                v0[tk][s4] = silu_(a0); v1[tk][s4] = silu_(a1);
            }
        if (sg < 2) {
            float ss[4][4];
#pragma unroll
            for (int tk = 0; tk < 4; ++tk)
#pragma unroll
                for (int s4 = 0; s4 < 4; ++s4) ss[tk][s4] = red16(v0[tk][s4] * v0[tk][s4] + v1[tk][s4] * v1[tk][s4]);
#pragma unroll
            for (int tk = 0; tk < 4; ++tk)
#pragma unroll
                for (int s4 = 0; s4 < 4; ++s4) { float t = ss[tk][s4]; t += __shfl_xor(t, 16); ss[tk][s4] = t; }
#pragma unroll
            for (int tk = 0; tk < 4; ++tk)
#pragma unroll
                for (int s4 = 0; s4 < 4; ++s4) {
                    float t = ss[tk][s4]; t += __shfl_xor(t, 32);
                    float sc = rsqrtf(t + 1e-12f);
                    if (sg == 0) sc *= 0.08838834764831845f;
                    v0[tk][s4] *= sc; v1[tk][s4] *= sc;
                }
        }
        bf16_t* dst = sg == 0 ? Dq : (sg == 1 ? Dk : Dv);
#pragma unroll
        for (int tk = 0; tk < 4; ++tk)
#pragma unroll
            for (int s4 = 0; s4 < 4; ++s4)
                *(unsigned*)(dst + (size_t)(R0 + tk) * 512 + s4 * 128 + lane * 2) = pack2(v0[tk][s4], v1[tk][s4]);
    }
    {
        unsigned zu[4][4];
#pragma unroll
        for (int tk = 0; tk < 4; ++tk)
#pragma unroll
            for (int hh = 0; hh < 4; ++hh) zu[tk][hh] = *(const unsigned*)(P + (size_t)(R0 + tk) * PW + PC + 1536 + hh * 128 + lane * 2);
#pragma unroll
        for (int tk = 0; tk < 4; ++tk)
#pragma unroll
            for (int hh = 0; hh < 4; ++hh)
                *(unsigned*)(SZ + (size_t)(R0 + tk) * 512 + hh * 128 + lane * 2) = pack2(silu_(lo2f(zu[tk][hh])), silu_(hi2f(zu[tk][hh])));
    }
    if (lane < 16) {
        const int R = R0 + (lane >> 2), hh = lane & 3;
        const float bb = bf2f(P[(size_t)R * PW + PBA + hh]);
        const float aa = bf2f(P[(size_t)R * PW + PBA + 4 + hh]);
        const float g = -__expf(p->in[I_ALOG][l * 4 + hh]) * softplus_(aa + p->in[I_DTB][l * 4 + hh]);
        Dsc[((size_t)R * 4 + hh) * 2] = sigmoid_(bb);
        Dsc[((size_t)R * 4 + hh) * 2 + 1] = __expf(g);
    }
}

template <int W, bool EDGE>
__device__ __forceinline__ void pooled_item(const bf16_t* P, const float* pbuf, bf16_t* pooled, int R, int c, int t, int seq0, bool samp) {
    unsigned u[W]; float2 f[W];
#pragma unroll
    for (int q = 0; q < W; ++q) {
        const int tau = t - q;
        if (EDGE) {
            u[q] = *(const unsigned*)(P + (size_t)(seq0 + (tau >= 0 ? tau : 0)) * PW + PB + c);
            int bi = 15 + tau; bi = bi < 0 ? 0 : (bi > 14 ? 14 : bi);
            f[q] = *(const float2*)(pbuf + (size_t)bi * 512 + c);
        } else {
            u[q] = *(const unsigned*)(P + (size_t)(R - q) * PW + PB + c);
        }
    }
    float s0 = 0.f, s1 = 0.f;
#pragma unroll
    for (int q = 0; q < W; ++q) {
        const int tau = t - q;
        float x0 = lo2f(u[q]), x1 = hi2f(u[q]);
        if (EDGE) { if (tau < 0) { x0 = samp ? f[q].x : 0.f; x1 = samp ? f[q].y : 0.f; } }
        s0 += x0; s1 += x1;
    }
    const float cnt = samp ? (float)W : (float)(t + 1 < W ? t + 1 : W);
    *(unsigned*)(pooled + (size_t)R * 512 + c) = pack2(s0 / cnt - lo2f(u[0]), s1 / cnt - hi2f(u[0]));
}

template <int W>
__device__ __forceinline__ void pooled_blk16(const bf16_t* P, bf16_t* pooled, int R0, int c) {
    const int t0 = R0 & 2047;
    float x0[31], x1[31];
#pragma unroll
    for (int i = 0; i < 31; ++i) {
        x0[i] = 0.f; x1[i] = 0.f;
        if (i >= 16 - W) {
            const int tt = t0 - 15 + i;
            const unsigned v = *(const unsigned*)(P + (size_t)(tt >= 0 ? R0 - 15 + i : R0) * PW + PB + c);
            x0[i] = tt >= 0 ? lo2f(v) : 0.f; x1[i] = tt >= 0 ? hi2f(v) : 0.f;
        }
    }
#pragma unroll
    for (int i = 0; i < 16; ++i) {
        float s0 = 0.f, s1 = 0.f;
#pragma unroll
        for (int q = 0; q < W; ++q) { s0 += x0[15 + i - q]; s1 += x1[15 + i - q]; }
        const int t = t0 + i;
        const float inv = 1.f / (float)(t + 1 < W ? t + 1 : W);
        *(unsigned*)(pooled + (size_t)(R0 + i) * 512 + c) = pack2(s0 * inv - x0[15 + i], s1 * inv - x1[15 + i]);
    }
}

__device__ __forceinline__ void attn_block_task(KP p, int l, int k) {
    const int tid_ = tidx();
    const int wid = tid_ >> 6;
    const bf16_t* P = (const bf16_t*)(p->ws + OFF_P);
    bf16_t* BO = (bf16_t*)(p->ws + OFF_BO);
    const int t = k * 4 + wid;
    if (t < 4096 + 512) {
            int rowbase, nvalid, h; const bf16_t* kb; const bf16_t* vt;
            if (t < 4096) {
                const int qt = t & 127, b = t >> 9; h = (t >> 7) & 3;
                const size_t kvo = ((size_t)((l * 8 + b) * 4 + h)) * 16384;
                rowbase = b * 2048 + qt * 16; nvalid = 16;
                kb = (const bf16_t*)(p->ws + OFF_KP) + kvo; vt = (const bf16_t*)(p->ws + OFF_VTP) + kvo;
            } else {
                const int u = t - 4096, b = u >> 2; h = u & 3;
                const size_t kvo = ((size_t)(b * 4 + h)) * 16384;
                rowbase = TPROMPT + b * 8; nvalid = 8;
                kb = (const bf16_t*)(p->ws + OFF_KS) + kvo; vt = (const bf16_t*)(p->ws + OFF_VTS) + kvo;
            }
            attn_task(P, rowbase, nvalid, kb, vt, BO, h);
    }
}
__device__ __forceinline__ void misc_vblock(KP p, int l, int vb, int nvb) {
    const int tid_ = tidx();
    const int tid = tid_;
    const bf16_t* P = (const bf16_t*)(p->ws + OFF_P);
    const size_t gt = (size_t)vb * 256 + tid, gs = (size_t)nvb * 256;
    {
        bf16_t* pooled = (bf16_t*)(p->ws + OFF_POOLED);
        for (size_t i = gt; i < (size_t)(TPROMPT / 16) * 256; i += gs) {
            const int R0 = (int)(i >> 8) * 16, c = (int)(i & 255) * 2, w = 2 << (c >> 7);
            if (w == 2) pooled_blk16<2>(P, pooled, R0, c);
            else if (w == 4) pooled_blk16<4>(P, pooled, R0, c);
            else if (w == 8) pooled_blk16<8>(P, pooled, R0, c);
            else pooled_blk16<16>(P, pooled, R0, c);
        }
        for (size_t i = gt; i < (size_t)(NTOK - TPROMPT) * 256; i += gs) {
            const int R = TPROMPT + (int)(i >> 8), c = (int)(i & 255) * 2, w = 2 << (c >> 7);
            const int rs = R - TPROMPT, t = rs & 7, sb = rs >> 3, seq0 = R - t;
            const float* pbuf = p->in[I_SPOOL] + (size_t)(l * 128 + sb) * 15 * 512;
            if (w == 2) pooled_item<2, true>(P, pbuf, pooled, R, c, t, seq0, true);
            else if (w == 4) pooled_item<4, true>(P, pbuf, pooled, R, c, t, seq0, true);
            else if (w == 8) pooled_item<8, true>(P, pbuf, pooled, R, c, t, seq0, true);
            else pooled_item<16, true>(P, pbuf, pooled, R, c, t, seq0, true);
        }
    }
    {
        float* out = p->out;
        for (size_t i = gt; i < (size_t)136 * 448; i += gs) {
            const int sq = (int)(i / 448), c = (int)(i % 448) * 4;
            const int row = sq < 8 ? sq * 2048 + 2047 : TPROMPT + (sq - 8) * 8 + 7;
            const uint2 u = *(const uint2*)(P + (size_t)row * PW + c);
            float* dst = sq < 8 ? out + O_PSHIFT + (size_t)(l * 8 + sq) * 1792 + c : out + O_SSHIFT + (size_t)(l * 128 + sq - 8) * 1792 + c;
            *(float4*)dst = make_float4(lo2f(u.x), hi2f(u.x), lo2f(u.y), hi2f(u.y));
        }
        for (size_t i = gt; i < (size_t)136 * 15 * 128; i += gs) {
            const int c = (int)(i & 127) * 4, r = (int)((i >> 7) % 15), sq = (int)((i >> 7) / 15);
            const int b = sq < 8 ? 0 : sq - 8;
            const int row = sq < 8 ? sq * 2048 + 2033 + r : TPROMPT + b * 8 + (r >= 7 ? r - 7 : 0);
            const uint2 u = *(const uint2*)(P + (size_t)row * PW + PB + c);
            const float4 sp = *(const float4*)(p->in[I_SPOOL] + ((size_t)(l * 128 + b) * 15 + (r < 7 ? 8 + r : 0)) * 512 + c);
            float4 v = make_float4(lo2f(u.x), hi2f(u.x), lo2f(u.y), hi2f(u.y));
            if (sq >= 8 && r < 7) v = sp;
            float* dst = sq < 8 ? out + O_PPOOL + ((size_t)(l * 8 + sq) * 15 + r) * 512 + c : out + O_SPOOL + ((size_t)(l * 128 + b) * 15 + r) * 512 + c;
            *(float4*)dst = v;
        }
        for (size_t i = gt; i < (size_t)136 * 3 * 384; i += gs) {
            const int c = (int)(i % 384) * 4, r = (int)((i / 384) % 3), sq = (int)(i / (3 * 384));
            const int row = sq < 8 ? sq * 2048 + 2045 + r : TPROMPT + (sq - 8) * 8 + 5 + r;
            const uint2 u = *(const uint2*)(P + (size_t)row * PW + PC + c);
            float* dst = sq < 8 ? out + O_PCONV + ((size_t)(l * 8 + sq) * 3 + r) * 1536 + c : out + O_SCONV + ((size_t)(l * 128 + sq - 8) * 3 + r) * 1536 + c;
            *(float4*)dst = make_float4(lo2f(u.x), hi2f(u.x), lo2f(u.y), hi2f(u.y));
        }
    }
}
__device__ __forceinline__ void phase_prep(KP p, int l, unsigned char* smem) {
    const int tid_ = tidx();
    const int wid = tid_ >> 6;
    for (int t = blockIdx.x; t < 1088 * 2; t += gridDim.x) rwkv_prep_task(p, l, t >> 1, t & 1, (bf16_t*)smem);
    const int gw = blockIdx.x * 4 + wid, nw = gridDim.x * 4;
    for (int q = gw; q < TPROMPT / 4 + (NTOK - TPROMPT); q += nw) {
        if (q < TPROMPT / 4) {
            const int R0 = q * 4;
            if ((R0 & 2047) == 0) { for (int k = 0; k < 4; ++k) delta_prep_row(p, l, R0 + k); }
            else delta_prep_quad(p, l, R0);
        } else delta_prep_row(p, l, TPROMPT + (q - TPROMPT / 4));
    }
}

typedef float f32x2 __attribute__((ext_vector_type(2)));
__device__ __forceinline__ float red8(float v) {
    v += dpp_mov<0xB1>(v);
    v += dpp_mov<0x4E>(v);
    v += dpp_mov<0x141>(v);
    return v;
}
__device__ __forceinline__ void rwkv_scan_task(KP p, int l, bool samp, int b, int h, int hb, float* sm) {
    const int tid_ = tidx();
    const int tid = tid_, lane = tid & 63, wid = tid >> 6, rr = lane >> 3, ks = lane & 7;
    const int L = samp ? 8 : 2048, row0 = samp ? TPROMPT + b * 8 : b * 2048;
    const int vrow = hb * 32 + wid * 8 + rr;
    const float* Rw = (const float*)(p->ws + OFF_RW);
    const bf16_t* Rkk = (const bf16_t*)(p->ws + OFF_RKK); const bf16_t* Rka = (const bf16_t*)(p->ws + OFF_RKA);
    const bf16_t* Rkp = (const bf16_t*)(p->ws + OFF_RKP); const bf16_t* Rr = (const bf16_t*)(p->ws + OFF_RR);
    const bf16_t* Rv = (const bf16_t*)(p->ws + OFF_RV);
    float* yraw = (float*)(p->ws + OFF_Y);
    f32x2 S[4];
#pragma unroll
    for (int i = 0; i < 4; ++i) S[i] = (f32x2){0.f, 0.f};
    if (samp) {
        const float* sp = p->in[I_SRWKV] + ((size_t)((l * 128 + b) * 8 + h) * 64 + vrow) * 64 + ks * 8;
        const float4 s0 = *(const float4*)sp, s1 = *(const float4*)(sp + 4);
        S[0] = (f32x2){s0.x, s0.y}; S[1] = (f32x2){s0.z, s0.w}; S[2] = (f32x2){s1.x, s1.y}; S[3] = (f32x2){s1.z, s1.w};
    }
    const int sstep = tid >> 4, sc = tid & 15;
    float4 pw; uint2 pkk, pka, pkp, pr; unsigned pv;
    const int ntile = (L + 15) >> 4;
    auto load_tile = [&](int tile) {
        const int step = tile * 16 + sstep;
        if (step < L) {
            const size_t o = (size_t)(row0 + step) * 512 + h * 64 + sc * 4;
            pw = *(const float4*)(Rw + o);
            pkk = *(const uint2*)(Rkk + o); pka = *(const uint2*)(Rka + o); pkp = *(const uint2*)(Rkp + o); pr = *(const uint2*)(Rr + o);
            pv = *(const unsigned*)(Rv + (size_t)(row0 + step) * 512 + h * 64 + hb * 32 + sc * 2);
        }
    };
    load_tile(0);
    for (int tile = 0; tile < ntile; ++tile) {
        float* bufp = sm + (tile & 1) * 5632;
        {
            const int o = sstep * 64 + sc * 4;
            *(float4*)(bufp + o) = pw;
            *(float4*)(bufp + 1024 + o) = make_float4(lo2f(pkk.x), hi2f(pkk.x), lo2f(pkk.y), hi2f(pkk.y));
            *(float4*)(bufp + 2048 + o) = make_float4(lo2f(pka.x), hi2f(pka.x), lo2f(pka.y), hi2f(pka.y));
            *(float4*)(bufp + 3072 + o) = make_float4(lo2f(pkp.x), hi2f(pkp.x), lo2f(pkp.y), hi2f(pkp.y));
            *(float4*)(bufp + 4096 + o) = make_float4(lo2f(pr.x), hi2f(pr.x), lo2f(pr.y), hi2f(pr.y));
            *(float2*)(bufp + 5120 + sstep * 32 + sc * 2) = make_float2(lo2f(pv), hi2f(pv));
        }
        __syncthreads();
        if (tile + 1 < ntile) load_tile(tile + 1);
        const int nst = (L - tile * 16) < 16 ? (L - tile * 16) : 16;
        for (int s0 = 0; s0 < nst; s0 += 4) {
#pragma unroll
            for (int s4 = 0; s4 < 4; ++s4) {
                const int s = s0 + s4;
                const float* bs = bufp + s * 64 + ks * 8;
                f32x2 w2[4], kk2[4], ka2[4], kp2[4], r2[4];
#pragma unroll
                for (int hh = 0; hh < 2; ++hh) {
                    const float4 a = *(const float4*)(bs + hh * 4);
                    const float4 bq = *(const float4*)(bs + 1024 + hh * 4);
                    const float4 c = *(const float4*)(bs + 2048 + hh * 4);
                    const float4 d = *(const float4*)(bs + 3072 + hh * 4);
                    const float4 e = *(const float4*)(bs + 4096 + hh * 4);
                    w2[2 * hh] = (f32x2){a.x, a.y}; w2[2 * hh + 1] = (f32x2){a.z, a.w};
                    kk2[2 * hh] = (f32x2){bq.x, bq.y}; kk2[2 * hh + 1] = (f32x2){bq.z, bq.w};
                    ka2[2 * hh] = (f32x2){c.x, c.y}; ka2[2 * hh + 1] = (f32x2){c.z, c.w};
                    kp2[2 * hh] = (f32x2){d.x, d.y}; kp2[2 * hh + 1] = (f32x2){d.z, d.w};
                    r2[2 * hh] = (f32x2){e.x, e.y}; r2[2 * hh + 1] = (f32x2){e.z, e.w};
                }
                const float vv = bufp[5120 + s * 32 + wid * 8 + rr];
                const f32x2 vv2 = (f32x2){vv, vv};
                f32x2 da = S[0] * kk2[0], db = S[1] * kk2[1];
                da = S[2] * kk2[2] + da; db = S[3] * kk2[3] + db;
                da = da + db;
                f32x2 u2[4];
#pragma unroll
                for (int i = 0; i < 4; ++i) u2[i] = S[i] * w2[i] + vv2 * kp2[i];
                const float d1 = red8(da.x + da.y);
                const f32x2 nd = (f32x2){-d1, -d1};
#pragma unroll
                for (int i = 0; i < 4; ++i) S[i] = nd * ka2[i] + u2[i];
                f32x2 ya = S[0] * r2[0], yb = S[1] * r2[1];
                ya = S[2] * r2[2] + ya; yb = S[3] * r2[3] + yb;
                ya = ya + yb;
                const float y = red8(ya.x + ya.y);
                yraw[(size_t)(row0 + tile * 16 + s) * 512 + h * 64 + vrow] = y;
            }
        }
    }
    float* so = (samp ? p->out + O_SRWKV + ((size_t)((l * 128 + b) * 8 + h) * 64 + vrow) * 64
                      : p->out + O_PRWKV + ((size_t)((l * 8 + b) * 8 + h) * 64 + vrow) * 64) + ks * 8;
    *(float4*)so = make_float4(S[0].x, S[0].y, S[1].x, S[1].y);
    *(float4*)(so + 4) = make_float4(S[2].x, S[2].y, S[3].x, S[3].y);
    __syncthreads();
}

__device__ __forceinline__ void delta_scan_task(KP p, int l, bool samp, int b, int h, int cgp, float* sm) {
    const int tid_ = tidx();
    const int tid = tid_, lane = tid & 63, wid = tid >> 6, cc = lane >> 3, ks = lane & 7;
    const int L = samp ? 8 : 2048, row0 = samp ? TPROMPT + b * 8 : b * 2048;
    const int e = cgp * 32 + wid * 8 + cc;
    const bf16_t* Dq = (const bf16_t*)(p->ws + OFF_DQ); const bf16_t* Dk = (const bf16_t*)(p->ws + OFF_DK); const bf16_t* Dv = (const bf16_t*)(p->ws + OFF_DV);
    const float* Dsc = (const float*)(p->ws + OFF_DSC);
    float* oraw = (float*)(p->ws + OFF_Y) + (size_t)NTOK * 512;
    f32x2 S[8];
    const size_t sbase = samp ? ((size_t)((l * 128 + b) * 4 + h) * 128) * 128 : ((size_t)((l * 8 + b) * 4 + h) * 128) * 128;
#pragma unroll
    for (int j = 0; j < 8; ++j) {
        S[j] = (f32x2){0.f, 0.f};
        if (samp) {
            S[j].x = p->in[I_SDELTA][sbase + (size_t)(ks * 16 + 2 * j) * 128 + e];
            S[j].y = p->in[I_SDELTA][sbase + (size_t)(ks * 16 + 2 * j + 1) * 128 + e];
        }
    }
    const int sstep = tid >> 4, sc = tid & 15;
    uint4 pk, pq; unsigned pv; float2 psc;
    const int ntile = (L + 15) >> 4;
    auto load_tile = [&](int tile) {
        const int step = tile * 16 + sstep;
        if (step < L) {
            const size_t o = (size_t)(row0 + step) * 512 + h * 128 + sc * 8;
            pk = *(const uint4*)(Dk + o); pq = *(const uint4*)(Dq + o);
            pv = *(const unsigned*)(Dv + (size_t)(row0 + step) * 512 + h * 128 + cgp * 32 + sc * 2);
        }
        if (tid < 16 && tile * 16 + tid < L) psc = *(const float2*)(Dsc + ((size_t)(row0 + tile * 16 + tid) * 4 + h) * 2);
    };
    load_tile(0);
    for (int tile = 0; tile < ntile; ++tile) {
        float* bufp = sm + (tile & 1) * 4640;
        {
            const int o = sstep * 128 + sc * 8;
            *(float4*)(bufp + o) = make_float4(lo2f(pk.x), hi2f(pk.x), lo2f(pk.y), hi2f(pk.y));
            *(float4*)(bufp + o + 4) = make_float4(lo2f(pk.z), hi2f(pk.z), lo2f(pk.w), hi2f(pk.w));
            *(float4*)(bufp + 2048 + o) = make_float4(lo2f(pq.x), hi2f(pq.x), lo2f(pq.y), hi2f(pq.y));
            *(float4*)(bufp + 2048 + o + 4) = make_float4(lo2f(pq.z), hi2f(pq.z), lo2f(pq.w), hi2f(pq.w));
            *(float2*)(bufp + 4096 + sstep * 32 + sc * 2) = make_float2(lo2f(pv), hi2f(pv));
            if (tid < 16) { bufp[4608 + tid] = psc.x; bufp[4624 + tid] = psc.y; }
        }
        __syncthreads();
        if (tile + 1 < ntile) load_tile(tile + 1);
        const int nst = (L - tile * 16) < 16 ? (L - tile * 16) : 16;
        for (int s0 = 0; s0 < nst; s0 += 4) {
#pragma unroll
            for (int s4 = 0; s4 < 4; ++s4) {
                const int s = s0 + s4;
                f32x2 k2[8], q2[8];
#pragma unroll
                for (int hh = 0; hh < 4; ++hh) {
                    const float4 a = *(const float4*)(bufp + s * 128 + ks * 16 + hh * 4);
                    const float4 c = *(const float4*)(bufp + 2048 + s * 128 + ks * 16 + hh * 4);
                    k2[2 * hh] = (f32x2){a.x, a.y}; k2[2 * hh + 1] = (f32x2){a.z, a.w};
                    q2[2 * hh] = (f32x2){c.x, c.y}; q2[2 * hh + 1] = (f32x2){c.z, c.w};
                }
                const float vv = bufp[4096 + s * 32 + wid * 8 + cc];
                const float beta = bufp[4608 + s], alpha = bufp[4624 + s];
                f32x2 d0 = S[0] * k2[0], d1v = S[1] * k2[1], d2 = S[2] * k2[2], d3 = S[3] * k2[3];
                d0 = S[4] * k2[4] + d0; d1v = S[5] * k2[5] + d1v; d2 = S[6] * k2[6] + d2; d3 = S[7] * k2[7] + d3;
                d0 = (d0 + d1v) + (d2 + d3);
                const f32x2 al2 = (f32x2){alpha, alpha};
                f32x2 sa[8];
#pragma unroll
                for (int j = 0; j < 8; ++j) sa[j] = S[j] * al2;
                const float dk = red8(d0.x + d0.y);
                const float vn = beta * (vv - alpha * dk);
                const f32x2 vn2 = (f32x2){vn, vn};
#pragma unroll
                for (int j = 0; j < 8; ++j) S[j] = k2[j] * vn2 + sa[j];
                f32x2 o0 = S[0] * q2[0], o1 = S[1] * q2[1], o2 = S[2] * q2[2], o3 = S[3] * q2[3];
                o0 = S[4] * q2[4] + o0; o1 = S[5] * q2[5] + o1; o2 = S[6] * q2[6] + o2; o3 = S[7] * q2[7] + o3;
                o0 = (o0 + o1) + (o2 + o3);
                const float o = red8(o0.x + o0.y);
                oraw[(size_t)(row0 + tile * 16 + s) * 512 + h * 128 + e] = o;
            }
        }
    }
    float* so = (samp ? p->out + O_SDELTA : p->out + O_PDELTA) + sbase;
#pragma unroll
    for (int j = 0; j < 8; ++j) {
        so[(size_t)(ks * 16 + 2 * j) * 128 + e] = S[j].x;
        so[(size_t)(ks * 16 + 2 * j + 1) * 128 + e] = S[j].y;
    }
    __syncthreads();
}

__device__ __forceinline__ void phase_scan(KP p, int l, unsigned char* smem) {
    __shared__ int s_q;
    const int tid_ = tidx();
    const int NLONG = 256, NT_RS = 2048, NT_DS = 2048;
    const int G = gridDim.x, bid = blockIdx.x;
    const bool split = G >= 2 * NLONG;
    if (split && bid < NLONG) {
        if (bid < 128) rwkv_scan_task(p, l, false, bid >> 4, (bid >> 1) & 7, bid & 1, (float*)smem);
        else { const int u = bid - 128; delta_scan_task(p, l, false, u >> 4, (u >> 2) & 3, u & 3, (float*)smem); }
    } else {
        const int first = split ? bid - NLONG : bid, stride = split ? G - NLONG : G;
        const int total = (split ? 0 : NLONG) + NT_RS + NT_DS;
        for (int t = first; t < total; t += stride) {
            int u = t;
            if (!split) {
                if (u < 128) { rwkv_scan_task(p, l, false, u >> 4, (u >> 1) & 7, u & 1, (float*)smem); continue; }
                if (u < 256) { const int v = u - 128; delta_scan_task(p, l, false, v >> 4, (v >> 2) & 3, v & 3, (float*)smem); continue; }
                u -= NLONG;
            }
            if (u < NT_RS) { rwkv_scan_task(p, l, true, u >> 4, (u >> 1) & 7, u & 1, (float*)smem); continue; }
            u -= NT_RS;
            delta_scan_task(p, l, true, u >> 4, (u >> 2) & 3, u & 3, (float*)smem);
        }
    }
    unsigned* cnt = (unsigned*)(p->ws + OFF_CNT) + l * 64;
    for (;;) {
        __syncthreads();
        if (tid_ == 0) s_q = (int)atomicAdd(cnt, 1u);
        __syncthreads();
        const int t = s_q;
        const int NGT = 136 * 32, NAT = 1152, NMV = 256;
        if (t >= NGT + NAT + NMV) break;
        if (t < NMV) misc_vblock(p, l, t, NMV);
        else if (t < NMV + NAT) attn_block_task(p, l, t - NMV);
        else gate_tile(t - NMV - NAT, (const bf16_t*)(p->ws + OFF_XB), (const bf16_t*)(p->ws + OFF_WG), (bf16_t*)(p->ws + OFF_G), (bf16_t*)smem);
    }
}

__device__ __forceinline__ void phase_post(KP p, int l, unsigned char* smem) {
    for (int t = blockIdx.x; t < 544; t += gridDim.x) {
        pool_gemm_tile(t, (const bf16_t*)(p->ws + OFF_POOLED), (const bf16_t*)(p->ws + OFF_POOLT), p->in[I_POOLS] + l * 512,
                       (bf16_t*)(p->ws + OFF_BO), (bf16_t*)smem);
        __syncthreads();
    }
    const int tid_ = tidx();
    const int lane = tid_ & 63, wid = tid_ >> 6;
    bf16_t* BO = (bf16_t*)(p->ws + OFF_BO);
    const float* yraw = (const float*)(p->ws + OFF_Y);
    const float* oraw = yraw + (size_t)NTOK * 512;
    const bf16_t* Rv = (const bf16_t*)(p->ws + OFF_RV); const bf16_t* Rg = (const bf16_t*)(p->ws + OFF_RG);
    const bf16_t* SZ = (const bf16_t*)(p->ws + OFF_SZ);
    const float* Rc = (const float*)(p->ws + OFF_RC);
    const int c0 = lane * 8;
    float gw[8], gb[8], nw[8];
    {
        const float4 a = *(const float4*)(p->in[I_GNW] + l * 512 + c0), a2 = *(const float4*)(p->in[I_GNW] + l * 512 + c0 + 4);
        const float4 bq = *(const float4*)(p->in[I_GNB] + l * 512 + c0), b2 = *(const float4*)(p->in[I_GNB] + l * 512 + c0 + 4);
        const float4 n1 = *(const float4*)(p->in[I_NORMW] + l * 128 + (c0 & 127)), n2 = *(const float4*)(p->in[I_NORMW] + l * 128 + (c0 & 127) + 4);
        gw[0] = a.x; gw[1] = a.y; gw[2] = a.z; gw[3] = a.w; gw[4] = a2.x; gw[5] = a2.y; gw[6] = a2.z; gw[7] = a2.w;
        gb[0] = bq.x; gb[1] = bq.y; gb[2] = bq.z; gb[3] = bq.w; gb[4] = b2.x; gb[5] = b2.y; gb[6] = b2.z; gb[7] = b2.w;
        nw[0] = n1.x; nw[1] = n1.y; nw[2] = n1.z; nw[3] = n1.w; nw[4] = n2.x; nw[5] = n2.y; nw[6] = n2.z; nw[7] = n2.w;
    }
    for (int R = blockIdx.x * 4 + wid; R < NTOK; R += gridDim.x * 4) {
        const size_t o = (size_t)R * 512 + c0;
        const float4 y0 = *(const float4*)(yraw + o), y1 = *(const float4*)(yraw + o + 4);
        const float4 d0 = *(const float4*)(oraw + o), d1 = *(const float4*)(oraw + o + 4);
        const u32x4 rv = *(const u32x4*)(Rv + o), rg = *(const u32x4*)(Rg + o), sz = *(const u32x4*)(SZ + o);
        const float bon = Rc[(size_t)R * 8 + (lane >> 3)];
        float y[8] = {y0.x, y0.y, y0.z, y0.w, y1.x, y1.y, y1.z, y1.w};
        float dl[8] = {d0.x, d0.y, d0.z, d0.w, d1.x, d1.y, d1.z, d1.w};
        float s = 0.f;
#pragma unroll
        for (int j = 0; j < 8; ++j) s += y[j];
        const float mean = red8(s) * (1.f / 64.f);
        float q = 0.f, dq = 0.f;
#pragma unroll
        for (int j = 0; j < 8; ++j) { y[j] -= mean; q += y[j] * y[j]; dq += dl[j] * dl[j]; }
        const float rstd = rsqrtf(red8(q) * (1.f / 64.f) + 64e-5f);
        const float rs = rsqrtf(red16(dq) * (1.f / 128.f) + 1e-6f);
        float oa[8], oc[8];
#pragma unroll
        for (int j = 0; j < 8; ++j) {
            const unsigned vu = rv[j >> 1], gu = rg[j >> 1], zu = sz[j >> 1];
            const float vv = (j & 1) ? hi2f(vu) : lo2f(vu), gg = (j & 1) ? hi2f(gu) : lo2f(gu), zz = (j & 1) ? hi2f(zu) : lo2f(zu);
            oa[j] = (y[j] * rstd * gw[j] + gb[j] + bon * vv) * gg;
            oc[j] = dl[j] * rs * nw[j] * zz;
        }
        u32x4 pa, pc;
#pragma unroll
        for (int j = 0; j < 4; ++j) { pa[j] = pack2(oa[2 * j], oa[2 * j + 1]); pc[j] = pack2(oc[2 * j], oc[2 * j + 1]); }
        *(u32x4*)(BO + (size_t)R * 1792 + c0) = pa;
        *(u32x4*)(BO + (size_t)R * 1792 + 1024 + c0) = pc;
    }
}

__device__ __forceinline__ void run_phase(KP p, int ph, unsigned char* smem) {
    unsigned char* ws = p->ws;
    bf16_t* xb = (bf16_t*)(ws + OFF_XB);
    float* X = p->out;
    float* Y = (float*)(ws + OFF_Y);
    bf16_t* P = (bf16_t*)(ws + OFF_P);
    bf16_t* H = P;
    const bool init = ph == 0;
    const int l = init ? 0 : (ph - 1) / NPH_LAYER, s = init ? -1 : (ph - 1) % NPH_LAYER;
    if (s == 0 || s == 10) {
        phase_ffn_in(xb, (const bf16_t*)(ws + (s == 0 ? OFF_WF1I : OFF_WF2I)), H, (bf16_t*)smem);
        if (s == 0 && l == 0) phase_memkv(p, (bf16_t*)smem);
    } else if (s == 1 || s == 8 || s == 11) {
        const bf16_t* A = s == 8 ? (const bf16_t*)(ws + OFF_MERGED) : H;
        const int K = s == 8 ? 1024 : 2048;
        const bf16_t* W = (const bf16_t*)(ws + (s == 1 ? OFF_WF1O : (s == 8 ? OFF_WO : OFF_WF2O)));
        phase_gemm_resid(A, K, K, W, X, Y, s == 8 ? 1.0f : 0.5f, (bf16_t*)smem);
    } else if (init || s == 2 || s == 9 || s == 12) {
        if (!init) {
            const int li = s == 2 ? 0 : (s == 9 ? 1 : 2);
            phase_ln(Y, X, xb, p->in[I_LNG] + (l * 3 + li) * 1024, p->in[I_LNB] + (l * 3 + li) * 1024);
        }
        if (s == 2) conv_sample_kv(p, l);
        if (init) phase_init(p, (float*)smem);
        if (init || (s == 12 && l < 3)) convert_layer_weights(p, init ? 0 : l + 1, (float*)smem);
    } else if (s == 3) {
        phase_proj(xb, (const bf16_t*)(ws + OFF_WP), P, (bf16_t*)smem);
    } else if (s == 4) {
        phase_prep(p, l, smem);
    } else if (s == 5) {
        phase_scan(p, l, smem);
    } else if (s == 6) {
        phase_post(p, l, smem);
    } else {
        phase_merge((const bf16_t*)(ws + OFF_G), (const bf16_t*)(ws + OFF_BO), (const bf16_t*)(ws + OFF_WB), (bf16_t*)(ws + OFF_MERGED), (bf16_t*)smem);
    }
}

#define XB_TMO      128
#define XB_XCNT(j)  (256  + 64 * (j))
#define XB_XSUB(j)  (1280 + 64 * (j))
#define XB_XGEN(j)  (2304 + 64 * (j))
#define XB_TOP      3328
#define XB_TOPGEN   3392
#define XCD_BAR_WORDS 3456
#define XB_SPIN_CAP (1u << 22)
#define LAS __attribute__((address_space(3)))
__device__ __forceinline__ unsigned xb_ld(unsigned* p)              { return __hip_atomic_load(p, __ATOMIC_RELAXED, __HIP_MEMORY_SCOPE_AGENT); }
__device__ __forceinline__ unsigned xb_add(unsigned* p, unsigned v) { return __hip_atomic_fetch_add(p, v, __ATOMIC_RELAXED, __HIP_MEMORY_SCOPE_AGENT); }
__device__ __forceinline__ unsigned xb_xcc_id() { return (unsigned)__builtin_amdgcn_s_getreg((3 << 11) | 20) & 0xFu; }
#define XB_SPIN(cond, bar) do { unsigned _sp = 0; while (cond) { __builtin_amdgcn_s_sleep(1); \
    if ((++_sp & 255u) == 0u) { if (xb_ld(&(bar)[XB_TMO])) break; if (_sp > XB_SPIN_CAP) { atomicAdd(&(bar)[XB_TMO], 1u); break; } } } } while (0)
struct XcdBarrier { unsigned* bar; unsigned x; volatile LAS unsigned* st; };
__device__ __forceinline__ XcdBarrier xcd_barrier_post(unsigned* bar, volatile LAS unsigned* st) {
    XcdBarrier b; b.bar = bar; b.x = xb_xcc_id(); b.st = st;
    if (threadIdx.x == 0) (void)xb_add(&bar[XB_XCNT(b.x)], 1u);
    return b;
}
__device__ __forceinline__ void xcd_barrier_complete(unsigned* bar, unsigned x, unsigned& nloc, unsigned& nx) {
    const unsigned G = gridDim.x * gridDim.y * gridDim.z;
    unsigned sum, cnt, mine, sp = 0u;
    for (;;) {
        sum = 0u; cnt = 0u; mine = 0u;
#pragma unroll
        for (unsigned j = 0; j < 16; ++j) { const unsigned c = xb_ld(&bar[XB_XCNT(j)]); sum += c; cnt += (c > 0u) ? 1u : 0u; mine = (j == x) ? c : mine; }
        if (sum == G) break;
        __builtin_amdgcn_s_sleep(1);
        if ((++sp & 255u) == 0u) { if (xb_ld(&bar[XB_TMO])) break; if (sp > XB_SPIN_CAP) { atomicAdd(&bar[XB_TMO], 1u); break; } }
    }
    nloc = mine > 0u ? mine : 1u; nx = cnt > 0u ? cnt : 1u;
}
__device__ __forceinline__ void xcd_barrier(const XcdBarrier& b) {
    asm volatile("s_waitcnt vmcnt(0)" ::: "memory");
    __syncthreads();
    if (threadIdx.x == 0) {
        unsigned* bar = b.bar;
        __builtin_amdgcn_s_waitcnt(0);
        unsigned nloc = b.st[0], nx = b.st[1];
        if (nloc == 0u) { xcd_barrier_complete(bar, b.x, nloc, nx); b.st[0] = nloc; b.st[1] = nx; }
        const unsigned old = xb_add(&bar[XB_XSUB(b.x)], 1u);
        const unsigned gen = old / nloc;
        if (old + 1u == (gen + 1u) * nloc) {
            __builtin_amdgcn_fence(__ATOMIC_RELEASE, "agent");
            asm volatile("s_waitcnt vmcnt(0)" ::: "memory");
            const unsigned og = xb_add(&bar[XB_TOP], 1u);
            const unsigned tg = og / nx;
            if (og + 1u == (tg + 1u) * nx) xb_add(&bar[XB_TOPGEN], 1u);
            else XB_SPIN(xb_ld(&bar[XB_TOPGEN]) == tg, bar);
            __builtin_amdgcn_fence(__ATOMIC_ACQUIRE, "agent");
            xb_add(&bar[XB_XGEN(b.x)], 1u);
            asm volatile("s_waitcnt vmcnt(0)" ::: "memory");
        } else {
            XB_SPIN(xb_ld(&bar[XB_XGEN(b.x)]) == gen, bar);
            __builtin_amdgcn_fence(__ATOMIC_ACQUIRE, "agent");
            asm volatile("s_waitcnt vmcnt(0)" ::: "memory");
        }
    }
    __syncthreads();
}

__global__ void __launch_bounds__(256, 2) mega(Params p, int ph_lo, int ph_hi) {
    __shared__ __attribute__((aligned(16))) unsigned char smem[45056];
    __shared__ uint4 xb_words;
    cg::grid_group grid = cg::this_grid();
    if (threadIdx.x == 0) xb_words = make_uint4(0u, 0u, 0u, 0u);
    __syncthreads();
    KP kp0 = (KP)__builtin_amdgcn_kernarg_segment_ptr();
    XcdBarrier xb = xcd_barrier_post((unsigned*)(kp0->ws + OFF_BAR), (volatile LAS unsigned*)&xb_words);
    if (ph_hi > 100000) grid.sync();
    for (int ph = ph_lo; ph < ph_hi; ++ph) {
#ifdef REPEAT_MASK
        const int nrep = (ph > 0 && ((REPEAT_MASK >> ((ph - 1) % NPH_LAYER)) & 1)) ? 2 : 1;
        for (int rep = 0; rep < nrep; ++rep)
#endif
        { KP kq = kp0; asm volatile("" : "+s"(kq)); run_phase(kq, ph, smem); }
        if (ph + 1 < ph_hi) xcd_barrier(xb);
    }
}

extern "C" void kernel_launch(void* const* d_in, const int* in_sizes, int n_in, void* d_out, int out_size, void* d_ws, size_t ws_size,
                              hipStream_t stream) {
    Params p{};
    for (int i = 0; i < 37; ++i) p.in[i] = (const float*)d_in[i];
    p.out = (float*)d_out; p.ws = (unsigned char*)d_ws;
    static int grid_blocks = 0;
    if (!grid_blocks) {
        int dev = 0, cus = 0, per_cu = 0;
        hipGetDevice(&dev);
        hipDeviceGetAttribute(&cus, hipDeviceAttributeMultiprocessorCount, dev);
        hipOccupancyMaxActiveBlocksPerMultiprocessor(&per_cu, mega, 256, 0);
        if (per_cu > 2) per_cu = 2;
        if (per_cu < 1) per_cu = 1;
        grid_blocks = cus * per_cu;
    }
    if (ws_size < WS_TOTAL) { fprintf(stderr, "workspace too small\n"); return; }
    (void)hipMemsetAsync((unsigned char*)d_ws + OFF_BAR, 0, (OFF_CNT - OFF_BAR) + 1024, stream);
#if MULTI_LAUNCH
    for (int ph = 0; ph < NPHASES; ++ph) {
        int lo = ph, hi = ph + 1;
        hipLaunchKernelGGL(mega, dim3(grid_blocks), dim3(256), 0, stream, p, lo, hi);
    }
#else
    int lo = 0, hi = NPHASES;
    void* args[] = {&p, &lo, &hi};
    hipError_t e = hipLaunchCooperativeKernel((void*)mega, dim3(grid_blocks), dim3(256), args, 0, stream);
    if (e != hipSuccess) fprintf(stderr, "cooperative launch failed: %s (grid %d)\n", hipGetErrorString(e), grid_blocks);
#endif
}
```

```cpp
#include <hip/hip_runtime.h>
#include <hip/hip_cooperative_groups.h>
#include <stdint.h>
#include <cstdio>
namespace cg = cooperative_groups;

typedef unsigned short bf16_t;
typedef short bf16x8 __attribute__((ext_vector_type(8)));
typedef float f32x4 __attribute__((ext_vector_type(4)));
typedef unsigned u32x4 __attribute__((ext_vector_type(4)));

#ifndef MULTI_LAUNCH
#define MULTI_LAUNCH 0
#endif

constexpr int NTOK = 17408;
constexpr int TPROMPT = 16384;
constexpr int PW = 4736;
constexpr int PB = 1792, PC = 2304, PM = 4352, PBA = 4608;
constexpr float ALPHA = 1.6817928305074292f;
constexpr int NPH_LAYER = 13;
constexpr int NPHASES = 1 + 4 * NPH_LAYER;

constexpr size_t O_YP = 0;
constexpr size_t O_YS = O_YP + (size_t)8 * 2048 * 1024;
constexpr size_t O_PRWKV = O_YS + (size_t)128 * 8 * 1024;
constexpr size_t O_PSHIFT = O_PRWKV + (size_t)4 * 8 * 8 * 4096;
constexpr size_t O_PPOOL = O_PSHIFT + (size_t)4 * 8 * 1792;
constexpr size_t O_PDELTA = O_PPOOL + (size_t)4 * 8 * 15 * 512;
constexpr size_t O_PCONV = O_PDELTA + (size_t)4 * 8 * 4 * 16384;
constexpr size_t O_PMK = O_PCONV + (size_t)4 * 8 * 3 * 1536;
constexpr size_t O_PMV = O_PMK + (size_t)4 * 8 * 256 * 256;
constexpr size_t O_SRWKV = O_PMV + (size_t)4 * 8 * 256 * 256;
constexpr size_t O_SSHIFT = O_SRWKV + (size_t)4 * 128 * 8 * 4096;
constexpr size_t O_SPOOL = O_SSHIFT + (size_t)4 * 128 * 1792;
constexpr size_t O_SDELTA = O_SPOOL + (size_t)4 * 128 * 15 * 512;
constexpr size_t O_SCONV = O_SDELTA + (size_t)4 * 128 * 4 * 16384;

constexpr size_t al(size_t x) { return (x + 255) & ~(size_t)255; }
constexpr size_t OFF_WF1I = 0;
constexpr size_t OFF_WF1O = OFF_WF1I + al((size_t)4096 * 1024 * 2);
constexpr size_t OFF_WF2I = OFF_WF1O + al((size_t)1024 * 2048 * 2);
constexpr size_t OFF_WF2O = OFF_WF2I + al((size_t)4096 * 1024 * 2);
constexpr size_t OFF_WP = OFF_WF2O + al((size_t)1024 * 2048 * 2);
constexpr size_t OFF_WG = OFF_WP + al((size_t)PW * 1024 * 2);
constexpr size_t OFF_WB = OFF_WG + al((size_t)4096 * 1024 * 2);
constexpr size_t OFF_WO = OFF_WB + al((size_t)1024 * 1792 * 2);
constexpr size_t OFF_POOLT = OFF_WO + al((size_t)1024 * 1024 * 2);
constexpr size_t OFF_WUP = OFF_POOLT + al((size_t)4 * 128 * 128 * 2);
constexpr size_t OFF_AUP = OFF_WUP + al((size_t)512 * 64 * 2);
constexpr size_t OFF_GUP = OFF_AUP + al((size_t)512 * 64 * 2);
constexpr size_t OFF_WKV = OFF_GUP + al((size_t)512 * 128 * 2);
constexpr size_t OFF_MEMB = OFF_WKV + al((size_t)4 * 512 * 1024 * 2);
constexpr size_t OFF_KP = OFF_MEMB + al((size_t)2048 * 1024 * 2);
constexpr size_t OFF_VTP = OFF_KP + al((size_t)4 * 8 * 4 * 16384 * 2);
constexpr size_t OFF_KS = OFF_VTP + al((size_t)4 * 8 * 4 * 16384 * 2);
constexpr size_t OFF_VTS = OFF_KS + al((size_t)128 * 4 * 16384 * 2);
constexpr size_t OFF_XB = OFF_VTS + al((size_t)128 * 4 * 16384 * 2);
constexpr size_t OFF_Y = OFF_XB + al((size_t)NTOK * 1024 * 2);
constexpr size_t OFF_P = OFF_Y + al((size_t)NTOK * 1024 * 4);
constexpr size_t OFF_BO = OFF_P + al((size_t)NTOK * PW * 2);
constexpr size_t OFF_MERGED = OFF_BO + al((size_t)NTOK * 1792 * 2);
constexpr size_t OFF_POOLED = OFF_MERGED + al((size_t)NTOK * 1024 * 2);
constexpr size_t OFF_RW = OFF_POOLED + al((size_t)NTOK * 512 * 2);
constexpr size_t OFF_RKK = OFF_RW + al((size_t)NTOK * 512 * 4);
constexpr size_t OFF_RKA = OFF_RKK + al((size_t)NTOK * 512 * 2);
constexpr size_t OFF_RKP = OFF_RKA + al((size_t)NTOK * 512 * 2);
constexpr size_t OFF_RR = OFF_RKP + al((size_t)NTOK * 512 * 2);
constexpr size_t OFF_RV = OFF_RR + al((size_t)NTOK * 512 * 2);
constexpr size_t OFF_RG = OFF_RV + al((size_t)NTOK * 512 * 2);
constexpr size_t OFF_RC = OFF_RG + al((size_t)NTOK * 512 * 2);
constexpr size_t OFF_DQ = OFF_RC + al((size_t)NTOK * 8 * 4);
constexpr size_t OFF_DK = OFF_DQ + al((size_t)NTOK * 512 * 2);
constexpr size_t OFF_DV = OFF_DK + al((size_t)NTOK * 512 * 2);
constexpr size_t OFF_DSC = OFF_DV + al((size_t)NTOK * 512 * 2);
constexpr size_t OFF_BAR = OFF_DSC + al((size_t)NTOK * 4 * 2 * 4);
constexpr size_t OFF_CNT = OFF_BAR + al((size_t)3456 * 4);
constexpr size_t OFF_SZ = OFF_CNT + 1024;
constexpr size_t OFF_G = OFF_SZ + al((size_t)NTOK * 512 * 2);
constexpr size_t WS_TOTAL = OFF_G + al((size_t)NTOK * 4096 * 2);

struct Params { const float* in[37]; float* out; unsigned char* ws; };
typedef const __attribute__((address_space(4))) Params* KP;

enum { I_XP = 0, I_XS, I_MEMP, I_CMK, I_CMV, I_SRWKV, I_SSHIFT, I_SPOOL, I_SDELTA, I_SCONV, I_WIN, I_MU, I_W0, I_WUP, I_A0,
       I_AUP, I_GUP, I_KK, I_KA, I_RK, I_GNW, I_GNB, I_POOLW, I_POOLS, I_CONVW, I_ALOG, I_DTB, I_NORMW, I_WKV, I_WBR,
       I_WOUT, I_F1I, I_F1O, I_F2I, I_F2O, I_LNG, I_LNB };

__device__ __forceinline__ float bf2f(bf16_t h) { return __uint_as_float(((unsigned)h) << 16); }
__device__ __forceinline__ bf16_t f2bf(float f) { unsigned u = __float_as_uint(f); u += 0x7fffu + ((u >> 16) & 1u); return (bf16_t)(u >> 16); }
typedef float f32x2_ __attribute__((ext_vector_type(2)));
typedef __bf16 bf16x2_ __attribute__((ext_vector_type(2)));
__device__ __forceinline__ unsigned pack2(float a, float b) {
    const f32x2_ v = {a, b};
    const bf16x2_ r = __builtin_convertvector(v, bf16x2_);
    return __builtin_bit_cast(unsigned, r);
}
__device__ __forceinline__ float lo2f(unsigned u) { return __uint_as_float(u << 16); }
__device__ __forceinline__ float hi2f(unsigned u) { return __uint_as_float(u & 0xffff0000u); }
__device__ __forceinline__ float sigmoid_(float x) { return __builtin_amdgcn_rcpf(1.f + __expf(-x)); }
__device__ __forceinline__ float silu_(float x) { return x * __builtin_amdgcn_rcpf(1.f + __expf(-x)); }
__device__ __forceinline__ float softplus_(float x) { return fmaxf(x, 0.f) + __logf(1.f + __expf(-fabsf(x))); }
__device__ __forceinline__ float tanh_(float x) { return 1.f - 2.f * __builtin_amdgcn_rcpf(1.f + __expf(2.f * x)); }

__device__ __forceinline__ int tidx() { int t = threadIdx.x; asm volatile("" : "+v"(t)); return t; }
__device__ __forceinline__ float ldnt(const float* p) { return __builtin_nontemporal_load(p); }
__device__ __forceinline__ float4 ldnt4(const float* p) { const f32x4 v = __builtin_nontemporal_load((const f32x4*)p); return make_float4(v[0], v[1], v[2], v[3]); }
__device__ __forceinline__ u32x4 ldntu4(const bf16_t* p) { return __builtin_nontemporal_load((const u32x4*)p); }
template <int CTRL> __device__ __forceinline__ float dpp_mov(float v) {
    return __int_as_float(__builtin_amdgcn_update_dpp(0, __float_as_int(v), CTRL, 0xf, 0xf, true));
}
__device__ __forceinline__ float red16(float v) {
    v += dpp_mov<0xB1>(v);
    v += dpp_mov<0x4E>(v);
    v += dpp_mov<0x141>(v);
    v += dpp_mov<0x140>(v);
    return v;
}
__device__ __forceinline__ float wave_sum(float v) {
    v = red16(v);
    v += __shfl_xor(v, 16);
    v += __shfl_xor(v, 32);
    return v;
}

__device__ __forceinline__ int mapcol(int kind, int n) {
    if (kind == 0) return n;
    if (kind == 1) return (n & 1) * 2048 + (n >> 1);
    if (kind == 2) { if (n < 4352) return n; if (n < 4608) return n + 8; if (n < 4616) return n - 256; return -1; }
    return n + 4616;
}
__device__ __forceinline__ void conv_job(const float* __restrict__ src, int ld, int K, bf16_t* dst, int Ndst, int kind, float* tile) {
    const int tid_ = tidx();
    const int tilesK = K >> 6, ntiles = tilesK * (Ndst >> 6);
    const int tx = tid_ & 63, ty = tid_ >> 6;
    const int tx2 = tid_ & 31, ty2 = tid_ >> 5;
    float r[16];
    int t = blockIdx.x;
    if (t < ntiles) {
        const int tk = t % tilesK, tn = t / tilesK, k0 = tk << 6, n0 = tn << 6;
        const int sc = mapcol(kind, n0 + tx);
#pragma unroll
        for (int i = 0; i < 16; ++i) r[i] = sc >= 0 ? ldnt(src + (size_t)(k0 + ty + 4 * i) * ld + sc) : 0.f;
    }
    for (; t < ntiles; t += gridDim.x) {
        const int tk = t % tilesK, tn = t / tilesK, k0 = tk << 6, n0 = tn << 6;
#pragma unroll
        for (int i = 0; i < 16; ++i) tile[(ty + 4 * i) * 65 + tx] = r[i];
        __syncthreads();
        const int tnext = t + gridDim.x;
        if (tnext < ntiles) {
            const int tk2 = tnext % tilesK, tn2 = tnext / tilesK, k2 = tk2 << 6, n2 = tn2 << 6;
            const int sc = mapcol(kind, n2 + tx);
#pragma unroll
            for (int i = 0; i < 16; ++i) r[i] = sc >= 0 ? ldnt(src + (size_t)(k2 + ty + 4 * i) * ld + sc) : 0.f;
        }
#pragma unroll
        for (int i = 0; i < 8; ++i) {
            const int nn = ty2 + 8 * i;
            *(unsigned*)(dst + (size_t)(n0 + nn) * K + k0 + 2 * tx2) = pack2(tile[(2 * tx2) * 65 + nn], tile[(2 * tx2 + 1) * 65 + nn]);
        }
        __syncthreads();
    }
}
__device__ __forceinline__ void convert_layer_weights(KP p, int l, float* tile) {
    unsigned char* ws = p->ws;
    conv_job(p->in[I_F1I] + (size_t)l * 1024 * 4096, 4096, 1024, (bf16_t*)(ws + OFF_WF1I), 4096, 1, tile);
    conv_job(p->in[I_F1O] + (size_t)l * 2048 * 1024, 1024, 2048, (bf16_t*)(ws + OFF_WF1O), 1024, 0, tile);
    conv_job(p->in[I_F2I] + (size_t)l * 1024 * 4096, 4096, 1024, (bf16_t*)(ws + OFF_WF2I), 4096, 1, tile);
    conv_job(p->in[I_F2O] + (size_t)l * 2048 * 1024, 1024, 2048, (bf16_t*)(ws + OFF_WF2O), 1024, 0, tile);
    conv_job(p->in[I_WIN] + (size_t)l * 1024 * 8712, 8712, 1024, (bf16_t*)(ws + OFF_WP), PW, 2, tile);
    conv_job(p->in[I_WIN] + (size_t)l * 1024 * 8712, 8712, 1024, (bf16_t*)(ws + OFF_WG), 4096, 3, tile);
    conv_job(p->in[I_WBR] + (size_t)l * 1792 * 1024, 1024, 1792, (bf16_t*)(ws + OFF_WB), 1024, 0, tile);
    conv_job(p->in[I_WOUT] + (size_t)l * 1024 * 1024, 1024, 1024, (bf16_t*)(ws + OFF_WO), 1024, 0, tile);
    for (int g = 0; g < 4; ++g)
        conv_job(p->in[I_POOLW] + (size_t)(l * 4 + g) * 16384, 128, 128, (bf16_t*)(ws + OFF_POOLT) + g * 16384, 128, 0, tile);
    conv_job(p->in[I_WUP] + (size_t)l * 64 * 512, 512, 64, (bf16_t*)(ws + OFF_WUP), 512, 0, tile);
    conv_job(p->in[I_AUP] + (size_t)l * 64 * 512, 512, 64, (bf16_t*)(ws + OFF_AUP), 512, 0, tile);
    conv_job(p->in[I_GUP] + (size_t)l * 128 * 512, 512, 128, (bf16_t*)(ws + OFF_GUP), 512, 0, tile);
}

__device__ __forceinline__ void phase_init(KP p, float* tile) {
    const int tid_ = tidx();
    unsigned char* ws = p->ws;
    for (int l = 0; l < 4; ++l)
        conv_job(p->in[I_WKV] + (size_t)l * 1024 * 512, 512, 1024, (bf16_t*)(ws + OFF_WKV) + (size_t)l * 512 * 1024, 512, 0, tile);
    const size_t gt = (size_t)blockIdx.x * 256 + tid_, gs = (size_t)gridDim.x * 256;
    {
        float4* X = (float4*)p->out; uint2* xb = (uint2*)(ws + OFF_XB);
        const float4* xp = (const float4*)p->in[I_XP]; const float4* xs = (const float4*)p->in[I_XS];
        const size_t np4 = (size_t)TPROMPT * 256, n4 = (size_t)NTOK * 256;
        for (size_t i0 = gt; i0 < n4; i0 += 4 * gs) {
            float4 v[4];
#pragma unroll
            for (int u = 0; u < 4; ++u) { const size_t i = i0 + u * gs; if (i < n4) v[u] = i < np4 ? ldnt4((const float*)(xp + i)) : ldnt4((const float*)(xs + (i - np4))); }
#pragma unroll
            for (int u = 0; u < 4; ++u) { const size_t i = i0 + u * gs; if (i < n4) { X[i] = v[u]; xb[i] = make_uint2(pack2(v[u].x, v[u].y), pack2(v[u].z, v[u].w)); } }
        }
    }
    {
        const float4* mp = (const float4*)p->in[I_MEMP]; uint2* mb = (uint2*)(ws + OFF_MEMB);
        for (size_t i = gt; i < (size_t)2048 * 256; i += gs) { float4 v = mp[i]; mb[i] = make_uint2(pack2(v.x, v.y), pack2(v.z, v.w)); }
    }
}

constexpr int LDT = 80;
__device__ __forceinline__ void lds_barrier() {
    asm volatile("s_waitcnt lgkmcnt(0)" ::: "memory");
    __builtin_amdgcn_s_barrier();
    asm volatile("" ::: "memory");
}
template <int NT>
__device__ __forceinline__ void gemm_compute(f32x4 (&acc)[4][NT], const bf16_t* sA, const bf16_t* sB, int wr, int wc, int fr, int fq) {
#pragma unroll
    for (int ks = 0; ks < 2; ++ks) {
        bf16x8 a[4], b[NT];
#pragma unroll
        for (int mt = 0; mt < 4; ++mt) a[mt] = *(const bf16x8*)(sA + (wr * 64 + mt * 16 + fr) * LDT + ks * 32 + fq * 8);
#pragma unroll
        for (int nt = 0; nt < NT; ++nt) b[nt] = *(const bf16x8*)(sB + (wc * 16 * NT + nt * 16 + fr) * LDT + ks * 32 + fq * 8);
        __builtin_amdgcn_s_setprio(1);
#pragma unroll
        for (int mt = 0; mt < 4; ++mt)
#pragma unroll
            for (int nt = 0; nt < NT; ++nt)
                acc[mt][nt] = __builtin_amdgcn_mfma_f32_16x16x32_bf16(b[nt], a[mt], acc[mt][nt], 0, 0, 0);
        __builtin_amdgcn_s_setprio(0);
    }
}
template <int NT>
__device__ __forceinline__ void gemm_tile(f32x4 (&acc)[4][NT], const bf16_t* A, int lda, const bf16_t* B, int ldb, int K, bf16_t* sm) {
    const int tid_ = tidx();
    bf16_t* sA = sm; bf16_t* sB = sm + 128 * LDT;
    const int tid = tid_, lane = tid & 63, wid = tid >> 6, wr = wid >> 1, wc = wid & 1;
    const int fr = lane & 15, fq = lane >> 4;
    const int lrow = tid >> 3, lkc = tid & 7;
    const bf16_t* ga = A + (size_t)lrow * lda + lkc * 8;
    const bf16_t* gb = B + (size_t)lrow * ldb + lkc * 8;
    int sbrow[NT];
#pragma unroll
    for (int i = 0; i < NT; ++i) { const int g = lrow + 32 * i, W_ = 16 * NT, rem = g % W_; sbrow[i] = (g / W_) * W_ + (rem % NT) * 16 + rem / NT; }
    u32x4 ra0[4], rb0[NT];
#pragma unroll
    for (int i = 0; i < 4; ++i) ra0[i] = *(const u32x4*)(ga + (size_t)(32 * i) * lda);
#pragma unroll
    for (int i = 0; i < NT; ++i) rb0[i] = *(const u32x4*)(gb + (size_t)(32 * i) * ldb);
    const int nk = K >> 6;
    for (int kt = 0; kt < nk; ++kt) {
        lds_barrier();
#pragma unroll
        for (int i = 0; i < 4; ++i) *(u32x4*)(sA + (lrow + 32 * i) * LDT + lkc * 8) = ra0[i];
#pragma unroll
        for (int i = 0; i < NT; ++i) *(u32x4*)(sB + sbrow[i] * LDT + lkc * 8) = rb0[i];
        lds_barrier();
        if (kt + 1 < nk) {
            ga += 64; gb += 64;
#pragma unroll
            for (int i = 0; i < 4; ++i) ra0[i] = *(const u32x4*)(ga + (size_t)(32 * i) * lda);
#pragma unroll
            for (int i = 0; i < NT; ++i) rb0[i] = *(const u32x4*)(gb + (size_t)(32 * i) * ldb);
        }
        __builtin_amdgcn_sched_barrier(0);
        gemm_compute<NT>(acc, sA, sB, wr, wc, fr, fq);
        __builtin_amdgcn_sched_barrier(0);
    }
}
template <int NT> __device__ __forceinline__ void zero_acc(f32x4 (&acc)[4][NT]) {
#pragma unroll
    for (int mt = 0; mt < 4; ++mt)
#pragma unroll
        for (int nt = 0; nt < NT; ++nt) acc[mt][nt] = (f32x4){0.f, 0.f, 0.f, 0.f};
}

template <int NT>
__device__ __forceinline__ void gather_cols(const f32x4 (&acc)[4][NT], int mt, float (&v)[4 * NT]) {
#pragma unroll
    for (int e = 0; e < 4 * NT; ++e) v[e] = acc[mt][e % NT][e / NT];
}
__device__ __forceinline__ void phase_ffn_in(const bf16_t* xb, const bf16_t* W, bf16_t* H, bf16_t* sm) {
    const int tid_ = tidx();
    const int lane = tid_ & 63, wid = tid_ >> 6, wr = wid >> 1, wc = wid & 1, fr = lane & 15, fq = lane >> 4;
    for (int t = blockIdx.x; t < 136 * 32; t += gridDim.x) {
        const int tm = t >> 5, tn = t & 31;
        f32x4 acc[4][4]; zero_acc<4>(acc);
        gemm_tile<4>(acc, xb + (size_t)tm * 128 * 1024, 1024, W + (size_t)tn * 128 * 1024, 1024, 1024, sm);
#pragma unroll
        for (int mt = 0; mt < 4; ++mt) {
            const int row = tm * 128 + wr * 64 + mt * 16 + fr;
            const int hc = tn * 64 + wc * 32 + fq * 8;
            float v[16]; gather_cols<4>(acc, mt, v);
            u32x4 o;
#pragma unroll
            for (int q = 0; q < 4; ++q) o[q] = pack2(silu_(v[4 * q]) * v[4 * q + 1], silu_(v[4 * q + 2]) * v[4 * q + 3]);
            *(u32x4*)(H + (size_t)row * 2048 + hc) = o;
        }
    }
}
template <int NT>
__device__ __forceinline__ void resid_tile(int tm, int col0, const bf16_t* A, int lda, int K, const bf16_t* W, const float* X, float* Y, float scale, bf16_t* sm) {
    const int tid_ = tidx();
    const int lane = tid_ & 63, wid = tid_ >> 6, wr = wid >> 1, wc = wid & 1, fr = lane & 15, fq = lane >> 4;
    f32x4 acc[4][NT]; zero_acc<NT>(acc);
    gemm_tile<NT>(acc, A + (size_t)tm * 128 * lda, lda, W + (size_t)col0 * K, K, K, sm);
#pragma unroll
    for (int mt = 0; mt < 4; ++mt) {
        const int row = tm * 128 + wr * 64 + mt * 16 + fr;
        const int cbase = col0 + wc * 16 * NT + fq * 4 * NT;
        const size_t o = (size_t)row * 1024 + cbase;
        float v[4 * NT]; gather_cols<NT>(acc, mt, v);
        float4 xv[NT];
#pragma unroll
        for (int q = 0; q < NT; ++q) xv[q] = *(const float4*)(X + o + 4 * q);
#pragma unroll
        for (int q = 0; q < NT; ++q)
            *(float4*)(Y + o + 4 * q) = make_float4(ALPHA * xv[q].x + scale * v[4 * q], ALPHA * xv[q].y + scale * v[4 * q + 1],
                                                    ALPHA * xv[q].z + scale * v[4 * q + 2], ALPHA * xv[q].w + scale * v[4 * q + 3]);
    }
}
__device__ __forceinline__ void phase_gemm_resid(const bf16_t* A, int lda, int K, const bf16_t* W, const float* X, float* Y, float scale, bf16_t* sm) {
    const int G = gridDim.x, NTILES = 136 * 8;
    const int nfull = (NTILES / G) * G;
    for (int t = blockIdx.x; t < nfull; t += G) resid_tile<4>(t >> 3, (t & 7) * 128, A, lda, K, W, X, Y, scale, sm);
    for (int u = blockIdx.x; u < 2 * (NTILES - nfull); u += G) {
        const int t = nfull + (u >> 1);
        resid_tile<2>(t >> 3, (t & 7) * 128 + (u & 1) * 64, A, lda, K, W, X, Y, scale, sm);
    }
}
__device__ __forceinline__ void phase_proj(const bf16_t* xb, const bf16_t* W, bf16_t* P, bf16_t* sm) {
    const int tid_ = tidx();
    const int lane = tid_ & 63, wid = tid_ >> 6, wr = wid >> 1, wc = wid & 1, fr = lane & 15, fq = lane >> 4;
    for (int t = blockIdx.x; t < 136 * 37; t += gridDim.x) {
        const int tm = t / 37, tn = t % 37;
        f32x4 acc[4][4]; zero_acc<4>(acc);
        gemm_tile<4>(acc, xb + (size_t)tm * 128 * 1024, 1024, W + (size_t)tn * 128 * 1024, 1024, 1024, sm);
#pragma unroll
        for (int mt = 0; mt < 4; ++mt) {
            const int row = tm * 128 + wr * 64 + mt * 16 + fr;
            const int cbase = tn * 128 + wc * 64 + fq * 16;
            float v[16]; gather_cols<4>(acc, mt, v);
            u32x4 o0, o1;
#pragma unroll
            for (int q = 0; q < 4; ++q) { o0[q] = pack2(v[2 * q], v[2 * q + 1]); o1[q] = pack2(v[8 + 2 * q], v[8 + 2 * q + 1]); }
            *(u32x4*)(P + (size_t)row * PW + cbase) = o0;
            *(u32x4*)(P + (size_t)row * PW + cbase + 8) = o1;
        }
    }
}
__device__ __forceinline__ void phase_memkv(KP p, bf16_t* sm) {
    const int tid_ = tidx();
    const int lane = tid_ & 63, wid = tid_ >> 6, wr = wid >> 1, wc = wid & 1, fr = lane & 15, fq = lane >> 4;
    const bf16_t* memb = (const bf16_t*)(p->ws + OFF_MEMB);
    const bf16_t* wkv = (const bf16_t*)(p->ws + OFF_WKV);
    bf16_t* Kp = (bf16_t*)(p->ws + OFF_KP); bf16_t* Vtp = (bf16_t*)(p->ws + OFF_VTP);
    for (int t = blockIdx.x; t < 4 * 16 * 4; t += gridDim.x) {
        const int l = t >> 6, tm = (t >> 2) & 15, tn = t & 3;
        f32x4 acc[4][4]; zero_acc<4>(acc);
        gemm_tile<4>(acc, memb + (size_t)tm * 128 * 1024, 1024, wkv + ((size_t)l * 512 + tn * 128) * 1024, 1024, 1024, sm);
#pragma unroll
        for (int mt = 0; mt < 4; ++mt) {
            const int row = tm * 128 + wr * 64 + mt * 16 + fr;
            const int cbase = tn * 128 + wc * 64 + fq * 16;
            float v[16]; gather_cols<4>(acc, mt, v);
            const int b = row >> 8, key = row & 255;
#pragma unroll
            for (int e = 0; e < 16; ++e) {
                const int col = cbase + e;
                if (col < 256) {
                    p->out[O_PMK + ((size_t)l * 2048 + row) * 256 + col] = v[e];
                    const int h = col >> 6, d = col & 63;
                    Kp[((size_t)((l * 8 + b) * 4 + h)) * 16384 + key * 64 + d] = f2bf(v[e]);
                } else {
                    const int c2 = col - 256;
                    p->out[O_PMV + ((size_t)l * 2048 + row) * 256 + c2] = v[e];
                    const int h = c2 >> 6, d = c2 & 63;
                    Vtp[((size_t)((l * 8 + b) * 4 + h)) * 16384 + d * 256 + key] = f2bf(v[e]);
                }
            }
        }
    }
}
__device__ __forceinline__ void gate_tile(int t, const bf16_t* xb, const bf16_t* Wg, bf16_t* G, bf16_t* sm) {
    const int tid_ = tidx();
    const int lane = tid_ & 63, wid = tid_ >> 6, wr = wid >> 1, wc = wid & 1, fr = lane & 15, fq = lane >> 4;
    const int tm = t >> 5, tn = t & 31;
    f32x4 acc[4][4]; zero_acc<4>(acc);
    gemm_tile<4>(acc, xb + (size_t)tm * 128 * 1024, 1024, Wg + (size_t)tn * 128 * 1024, 1024, 1024, sm);
#pragma unroll
    for (int mt = 0; mt < 4; ++mt) {
        const int row = tm * 128 + wr * 64 + mt * 16 + fr;
        const int cbase = tn * 128 + wc * 64 + fq * 16;
        float v[16]; gather_cols<4>(acc, mt, v);
        u32x4 o0, o1;
#pragma unroll
        for (int q = 0; q < 4; ++q) {
            o0[q] = pack2(sigmoid_(v[2 * q]), sigmoid_(v[2 * q + 1]));
            o1[q] = pack2(sigmoid_(v[8 + 2 * q]), sigmoid_(v[8 + 2 * q + 1]));
        }
        *(u32x4*)(G + (size_t)row * 4096 + cbase) = o0;
        *(u32x4*)(G + (size_t)row * 4096 + cbase + 8) = o1;
    }
}
__device__ __forceinline__ void phase_merge(const bf16_t* G, const bf16_t* BO, const bf16_t* Wb, bf16_t* M, bf16_t* sm) {
    const int tid_ = tidx();
    const int lane = tid_ & 63, wid = tid_ >> 6, wr = wid >> 1, wc = wid & 1, fr = lane & 15, fq = lane >> 4;
    for (int t = blockIdx.x; t < 136 * 16; t += gridDim.x) {
        const int tm = t >> 4, tn = t & 15;
        const int cbase = tn * 64 + wc * 32 + fq * 8;
        f32x4 accm[4][2]; zero_acc<2>(accm);
#pragma unroll 1
        for (int i = 0; i < 4; ++i) {
            f32x4 accb[4][2]; zero_acc<2>(accb);
            const int koff = i * 512, kk = i < 3 ? 512 : 256;
            gemm_tile<2>(accb, BO + (size_t)tm * 128 * 1792 + koff, 1792, Wb + (size_t)tn * 64 * 1792 + koff, 1792, kk, sm);
#pragma unroll
            for (int mt = 0; mt < 4; ++mt) {
                const int row = tm * 128 + wr * 64 + mt * 16 + fr;
                const u32x4 gu = ldntu4(G + (size_t)row * 4096 + i * 1024 + cbase);
#pragma unroll
                for (int e = 0; e < 8; ++e) {
                    const float gv = (e & 1) ? hi2f(gu[e >> 1]) : lo2f(gu[e >> 1]);
                    accm[mt][e % 2][e / 2] += gv * accb[mt][e % 2][e / 2];
                }
            }
        }
#pragma unroll
        for (int mt = 0; mt < 4; ++mt) {
            const int row = tm * 128 + wr * 64 + mt * 16 + fr;
            float v[8]; gather_cols<2>(accm, mt, v);
            u32x4 o;
#pragma unroll
            for (int q = 0; q < 4; ++q) o[q] = pack2(v[2 * q], v[2 * q + 1]);
            *(u32x4*)(M + (size_t)row * 1024 + cbase) = o;
        }
    }
}
__device__ __forceinline__ void pool_gemm_tile(int t, const bf16_t* pooled, const bf16_t* PoolT, const float* pscale, bf16_t* BO, bf16_t* sm) {
    const int tid_ = tidx();
    const int lane = tid_ & 63, wid = tid_ >> 6, wr = wid >> 1, wc = wid & 1, fr = lane & 15, fq = lane >> 4;
    const int tm = t >> 2, g = t & 3;
    f32x4 acc[4][4]; zero_acc<4>(acc);
    gemm_tile<4>(acc, pooled + (size_t)tm * 128 * 512 + g * 128, 512, PoolT + g * 16384, 128, 128, sm);
    const int cbase = g * 128 + wc * 64 + fq * 16;
    float ps[16];
#pragma unroll
    for (int q = 0; q < 4; ++q) { const float4 s4 = *(const float4*)(pscale + cbase + 4 * q); ps[4 * q] = s4.x; ps[4 * q + 1] = s4.y; ps[4 * q + 2] = s4.z; ps[4 * q + 3] = s4.w; }
#pragma unroll
    for (int mt = 0; mt < 4; ++mt) {
        const int row = tm * 128 + wr * 64 + mt * 16 + fr;
        float v[16]; gather_cols<4>(acc, mt, v);
        u32x4 o0, o1;
#pragma unroll
        for (int q = 0; q < 4; ++q) {
            o0[q] = pack2(v[2 * q] * ps[2 * q], v[2 * q + 1] * ps[2 * q + 1]);
            o1[q] = pack2(v[8 + 2 * q] * ps[8 + 2 * q], v[8 + 2 * q + 1] * ps[8 + 2 * q + 1]);
        }
        *(u32x4*)(BO + (size_t)row * 1792 + 512 + cbase) = o0;
        *(u32x4*)(BO + (size_t)row * 1792 + 512 + cbase + 8) = o1;
    }
}

__device__ __forceinline__ void phase_ln(const float* Y, float* X, bf16_t* xb, const float* g, const float* b) {
    const int tid_ = tidx();
    const int lane = tid_ & 63, wid = tid_ >> 6;
    const int stride = gridDim.x * 4;
    int row = blockIdx.x * 4 + wid;
    float4 v[4], vn[4];
    if (row < NTOK) {
#pragma unroll
        for (int i = 0; i < 4; ++i) v[i] = ldnt4(Y + (size_t)row * 1024 + (lane + 64 * i) * 4);
    }
    float4 gg[4], bb[4];
#pragma unroll
    for (int i = 0; i < 4; ++i) { gg[i] = ((const float4*)g)[lane + 64 * i]; bb[i] = ((const float4*)b)[lane + 64 * i]; }
    for (; row < NTOK; row += stride) {
        const int nrow = row + stride;
        if (nrow < NTOK) {
#pragma unroll
            for (int i = 0; i < 4; ++i) vn[i] = ldnt4(Y + (size_t)nrow * 1024 + (lane + 64 * i) * 4);
        }
        float s = 0.f;
#pragma unroll
        for (int i = 0; i < 4; ++i) s += v[i].x + v[i].y + v[i].z + v[i].w;
        const float mean = wave_sum(s) * (1.f / 1024.f);
        float q = 0.f;
#pragma unroll
        for (int i = 0; i < 4; ++i) {
            v[i].x -= mean; v[i].y -= mean; v[i].z -= mean; v[i].w -= mean;
            q += v[i].x * v[i].x + v[i].y * v[i].y + v[i].z * v[i].z + v[i].w * v[i].w;
        }
        const float rstd = rsqrtf(wave_sum(q) * (1.f / 1024.f) + 1e-5f);
#pragma unroll
        for (int i = 0; i < 4; ++i) {
            const int c4 = lane + 64 * i;
            float4 o;
            o.x = v[i].x * rstd * gg[i].x + bb[i].x; o.y = v[i].y * rstd * gg[i].y + bb[i].y;
            o.z = v[i].z * rstd * gg[i].z + bb[i].z; o.w = v[i].w * rstd * gg[i].w + bb[i].w;
            ((float4*)(X + (size_t)row * 1024))[c4] = o;
            ((uint2*)(xb + (size_t)row * 1024))[c4] = make_uint2(pack2(o.x, o.y), pack2(o.z, o.w));
        }
#pragma unroll
        for (int i = 0; i < 4; ++i) v[i] = vn[i];
    }
}

__device__ __forceinline__ void conv_sample_kv(KP p, int l) {
    const int tid_ = tidx();
    const size_t gt = (size_t)blockIdx.x * 256 + tid_, gs = (size_t)gridDim.x * 256;
    const float* ck = p->in[I_CMK] + (size_t)l * 128 * 256 * 256;
    const float* cv = p->in[I_CMV] + (size_t)l * 128 * 256 * 256;
    bf16_t* Ks = (bf16_t*)(p->ws + OFF_KS); bf16_t* Vts = (bf16_t*)(p->ws + OFF_VTS);
    for (size_t i0 = gt; i0 < (size_t)128 * 256 * 64; i0 += 4 * gs) {
        float4 v[4];
#pragma unroll
        for (int u = 0; u < 4; ++u) { const size_t i = i0 + u * gs; if (i < (size_t)128 * 256 * 64) v[u] = ldnt4(ck + i * 4); }
#pragma unroll
        for (int u = 0; u < 4; ++u) {
            const size_t i = i0 + u * gs;
            if (i < (size_t)128 * 256 * 64) {
                const int d4 = i & 15, h = (i >> 4) & 3, key = (i >> 6) & 255, b = (int)(i >> 14);
                *(uint2*)(Ks + ((size_t)(b * 4 + h) * 256 + key) * 64 + d4 * 4) = make_uint2(pack2(v[u].x, v[u].y), pack2(v[u].z, v[u].w));
            }
        }
    }
    for (size_t i0 = gt; i0 < (size_t)128 * 64 * 256; i0 += 4 * gs) {
        float v[4][4];
#pragma unroll
        for (int u = 0; u < 4; ++u) {
            const size_t i = i0 + u * gs;
            if (i < (size_t)128 * 64 * 256) {
                const int d = i & 63, h = (i >> 6) & 3, kq = (i >> 8) & 63, b = (int)(i >> 14);
#pragma unroll
                for (int j = 0; j < 4; ++j) v[u][j] = ldnt(cv + ((size_t)(b * 256 + kq * 4 + j) * 4 + h) * 64 + d);
            }
        }
#pragma unroll
        for (int u = 0; u < 4; ++u) {
            const size_t i = i0 + u * gs;
            if (i < (size_t)128 * 64 * 256) {
                const int d = i & 63, h = (i >> 6) & 3, kq = (i >> 8) & 63, b = (int)(i >> 14);
                *(uint2*)(Vts + ((size_t)(b * 4 + h) * 64 + d) * 256 + kq * 4) = make_uint2(pack2(v[u][0], v[u][1]), pack2(v[u][2], v[u][3]));
            }
        }
    }
}

__device__ __forceinline__ void attn_task(const bf16_t* P, int rowbase, int nvalid, const bf16_t* Kb, const bf16_t* Vt, bf16_t* BO, int h) {
    const int tid_ = tidx();
    const int lane = tid_ & 63, fr = lane & 15, fq = lane >> 4;
    const int qrow = rowbase + (fr < nvalid ? fr : nvalid - 1);
    const bf16_t* qp = P + (size_t)qrow * PW + PM + h * 64 + fq * 8;
    const bf16x8 qb0 = *(const bf16x8*)qp, qb1 = *(const bf16x8*)(qp + 32);
    f32x4 s[16];
#pragma unroll
    for (int mt = 0; mt < 16; ++mt) {
        const bf16_t* kp = Kb + (mt * 16 + fr) * 64 + fq * 8;
        const bf16x8 a0 = *(const bf16x8*)kp, a1 = *(const bf16x8*)(kp + 32);
        f32x4 z = {0.f, 0.f, 0.f, 0.f};
        z = __builtin_amdgcn_mfma_f32_16x16x32_bf16(a0, qb0, z, 0, 0, 0);
        s[mt] = __builtin_amdgcn_mfma_f32_16x16x32_bf16(a1, qb1, z, 0, 0, 0);
    }
    float mx = -3.0e38f;
#pragma unroll
    for (int mt = 0; mt < 16; ++mt)
#pragma unroll
        for (int j = 0; j < 4; ++j) { s[mt][j] *= 0.125f; mx = fmaxf(mx, s[mt][j]); }
    mx = fmaxf(mx, __shfl_xor(mx, 16)); mx = fmaxf(mx, __shfl_xor(mx, 32));
    float sum = 0.f;
#pragma unroll
    for (int mt = 0; mt < 16; ++mt)
#pragma unroll
        for (int j = 0; j < 4; ++j) { const float e = __expf(s[mt][j] - mx); s[mt][j] = e; sum += e; }
    sum += __shfl_xor(sum, 16); sum += __shfl_xor(sum, 32);
    f32x4 o[4];
#pragma unroll
    for (int dt = 0; dt < 4; ++dt) o[dt] = (f32x4){0.f, 0.f, 0.f, 0.f};
#pragma unroll
    for (int st = 0; st < 8; ++st) {
        union { bf16x8 v; unsigned u[4]; } pb;
        pb.u[0] = pack2(s[2 * st][0], s[2 * st][1]); pb.u[1] = pack2(s[2 * st][2], s[2 * st][3]);
        pb.u[2] = pack2(s[2 * st + 1][0], s[2 * st + 1][1]); pb.u[3] = pack2(s[2 * st + 1][2], s[2 * st + 1][3]);
#pragma unroll
        for (int dt = 0; dt < 4; ++dt) {
            const bf16_t* vp = Vt + (dt * 16 + fr) * 256 + st * 32 + fq * 4;
            union { bf16x8 v; uint2 u[2]; } av;
            av.u[0] = *(const uint2*)vp; av.u[1] = *(const uint2*)(vp + 16);
            o[dt] = __builtin_amdgcn_mfma_f32_16x16x32_bf16(av.v, pb.v, o[dt], 0, 0, 0);
        }
    }
    const float inv = 1.f / sum;
    if (fr < nvalid) {
#pragma unroll
        for (int dt = 0; dt < 4; ++dt)
            *(uint2*)(BO + (size_t)(rowbase + fr) * 1792 + 1536 + h * 64 + dt * 16 + fq * 4) =
                make_uint2(pack2(o[dt][0] * inv, o[dt][1] * inv), pack2(o[dt][2] * inv, o[dt][3] * inv));
    }
}

__device__ __forceinline__ void rwkv_prep_task(KP p, int l, int tile, int hg, bf16_t* sAp) {
    const int tid_ = tidx();
    const int tid = tid_, lane = tid & 63, wid = tid >> 6, fr = lane & 15, fq = lane >> 4;
    const bf16_t* P = (const bf16_t*)(p->ws + OFF_P);
    const float* mu = p->in[I_MU] + l * 1792;
    const float* shs = p->in[I_SSHIFT] + (size_t)l * 128 * 1792;
    const int row0 = tile * 16;
    const bool samp = row0 >= TPROMPT;
    const int sb0 = samp ? (row0 - TPROMPT) >> 3 : 0;
    {
        const int c = tid, col = 1536 + c;
        const float m = mu[col];
        float cur[17];
#pragma unroll
        for (int i = 0; i < 17; ++i) cur[i] = bf2f(P[(size_t)(row0 + i > 0 ? row0 + i - 1 : 0) * PW + col]);
        const float sh0 = shs[(size_t)sb0 * 1792 + col], sh1 = shs[(size_t)(sb0 + 1 < 128 ? sb0 + 1 : 127) * 1792 + col];
#pragma unroll
        for (int i = 0; i < 16; ++i) {
            float pv = cur[i];
            if (!samp) { if (((row0 + i) & 2047) == 0) pv = 0.f; }
            else { if (i == 0) pv = sh0; if (i == 8) pv = sh1; }
            const float xm = cur[i + 1] + (pv - cur[i + 1]) * m;
            const float val = c < 64 ? tanh_(xm) : (c < 128 ? xm : sigmoid_(xm));
            sAp[i * 264 + c] = f2bf(val);
        }
    }
    __syncthreads();
    const int h = hg * 4 + wid;
    bf16x8 af[8];
#pragma unroll
    for (int ks = 0; ks < 8; ++ks) af[ks] = *(const bf16x8*)(sAp + fr * 264 + ks * 32 + fq * 8);
    const bf16_t* WupT = (const bf16_t*)(p->ws + OFF_WUP);
    const bf16_t* AupT = (const bf16_t*)(p->ws + OFF_AUP);
    const bf16_t* GupT = (const bf16_t*)(p->ws + OFF_GUP);
    f32x4 az[4], aa[4], ag[4];
#pragma unroll
    for (int nt = 0; nt < 4; ++nt) {
        const int n = h * 64 + fr * 4 + nt;
        f32x4 z = {0.f, 0.f, 0.f, 0.f};
        z = __builtin_amdgcn_mfma_f32_16x16x32_bf16(*(const bf16x8*)(WupT + n * 64 + fq * 8), af[0], z, 0, 0, 0);
        z = __builtin_amdgcn_mfma_f32_16x16x32_bf16(*(const bf16x8*)(WupT + n * 64 + 32 + fq * 8), af[1], z, 0, 0, 0);
        az[nt] = z;
        f32x4 a = {0.f, 0.f, 0.f, 0.f};
        a = __builtin_amdgcn_mfma_f32_16x16x32_bf16(*(const bf16x8*)(AupT + n * 64 + fq * 8), af[2], a, 0, 0, 0);
        a = __builtin_amdgcn_mfma_f32_16x16x32_bf16(*(const bf16x8*)(AupT + n * 64 + 32 + fq * 8), af[3], a, 0, 0, 0);
        aa[nt] = a;
        f32x4 g = {0.f, 0.f, 0.f, 0.f};
#pragma unroll
        for (int ks = 0; ks < 4; ++ks)
            g = __builtin_amdgcn_mfma_f32_16x16x32_bf16(*(const bf16x8*)(GupT + n * 128 + ks * 32 + fq * 8), af[4 + ks], g, 0, 0, 0);
        ag[nt] = g;
    }
    float* Rw = (float*)(p->ws + OFF_RW);
    bf16_t* Rkk = (bf16_t*)(p->ws + OFF_RKK); bf16_t* Rka = (bf16_t*)(p->ws + OFF_RKA); bf16_t* Rkp = (bf16_t*)(p->ws + OFF_RKP);
    bf16_t* Rr = (bf16_t*)(p->ws + OFF_RR); bf16_t* Rv = (bf16_t*)(p->ws + OFF_RV); bf16_t* Rg = (bf16_t*)(p->ws + OFF_RG);
    float* Rc = (float*)(p->ws + OFF_RC);
    const int R = row0 + fr;
    bool first; int sb = 0;
    if (!samp) first = (R & 2047) == 0; else { const int rs = R - TPROMPT; first = (rs & 7) == 0; sb = rs >> 3; }
    const int cb = h * 64 + fq * 16;
    float x3[3][16];
#pragma unroll
    for (int q = 0; q < 3; ++q) {
        const int col = q * 512 + cb;
        const u32x4 c0 = *(const u32x4*)(P + (size_t)R * PW + col), c1 = *(const u32x4*)(P + (size_t)R * PW + col + 8);
        const u32x4 p0 = *(const u32x4*)(P + (size_t)(R > 0 ? R - 1 : 0) * PW + col), p1 = *(const u32x4*)(P + (size_t)(R > 0 ? R - 1 : 0) * PW + col + 8);
#pragma unroll
        for (int e4 = 0; e4 < 4; ++e4) {
            const float4 su = *(const float4*)(shs + (size_t)sb * 1792 + col + e4 * 4);
            const float4 m4 = *(const float4*)(mu + col + e4 * 4);
            const float sv[4] = {su.x, su.y, su.z, su.w}, mm[4] = {m4.x, m4.y, m4.z, m4.w};
#pragma unroll
            for (int k = 0; k < 4; ++k) {
                const int e = e4 * 4 + k;
                const unsigned cu = e < 8 ? c0[e >> 1] : c1[(e - 8) >> 1], pu = e < 8 ? p0[e >> 1] : p1[(e - 8) >> 1];
                const float cv = (e & 1) ? hi2f(cu) : lo2f(cu), pp = (e & 1) ? hi2f(pu) : lo2f(pu);
                const float prev = first ? (samp ? sv[k] : 0.f) : pp;
                x3[q][e] = cv + (prev - cv) * mm[k];
            }
        }
    }
    float wd[16], kp[16], kkv[16], av[16], gv[16];
    float ss = 0.f, bon = 0.f;
#pragma unroll
    for (int e4 = 0; e4 < 4; ++e4) {
        const float4 w04 = *(const float4*)(p->in[I_W0] + l * 512 + cb + e4 * 4), a04 = *(const float4*)(p->in[I_A0] + l * 512 + cb + e4 * 4);
        const float4 kk4 = *(const float4*)(p->in[I_KK] + l * 512 + cb + e4 * 4), ka4 = *(const float4*)(p->in[I_KA] + l * 512 + cb + e4 * 4);
        const float4 rk4 = *(const float4*)(p->in[I_RK] + l * 512 + cb + e4 * 4);
        const float w0v[4] = {w04.x, w04.y, w04.z, w04.w}, a0v[4] = {a04.x, a04.y, a04.z, a04.w};
        const float kkp[4] = {kk4.x, kk4.y, kk4.z, kk4.w}, kap[4] = {ka4.x, ka4.y, ka4.z, ka4.w}, rkp[4] = {rk4.x, rk4.y, rk4.z, rk4.w};
#pragma unroll
        for (int k = 0; k < 4; ++k) {
            const int e = e4 * 4 + k;
            const float z = w0v[k] + az[k][e4];
            wd[e] = __expf(-__expf(-softplus_(-z) - 0.5f));
            const float a = sigmoid_(a0v[k] + aa[k][e4]);
            const float kx = x3[1][e];
            kkv[e] = kx * kkp[k];
            kp[e] = kx * (1.f + (a - 1.f) * kap[k]);
            av[e] = a; gv[e] = ag[k][e4];
            ss += kkv[e] * kkv[e];
            bon += x3[0][e] * kp[e] * rkp[k];
        }
    }
    ss += __shfl_xor(ss, 16); ss += __shfl_xor(ss, 32);
    bon += __shfl_xor(bon, 16); bon += __shfl_xor(bon, 32);
    const float inv = rsqrtf(ss + 1e-12f);
    const size_t o = (size_t)R * 512 + cb;
#pragma unroll
    for (int e4 = 0; e4 < 4; ++e4) *(float4*)(Rw + o + e4 * 4) = make_float4(wd[e4 * 4], wd[e4 * 4 + 1], wd[e4 * 4 + 2], wd[e4 * 4 + 3]);
#pragma unroll
    for (int hf = 0; hf < 2; ++hf) {
        u32x4 vkk, vka, vkp, vr, vv, vg;
#pragma unroll
        for (int k = 0; k < 4; ++k) {
            const int e = hf * 8 + k * 2;
            const float k0 = kkv[e] * inv, k1 = kkv[e + 1] * inv;
            vkk[k] = pack2(k0, k1); vka[k] = pack2(k0 * av[e], k1 * av[e + 1]); vkp[k] = pack2(kp[e], kp[e + 1]);
            vr[k] = pack2(x3[0][e], x3[0][e + 1]); vv[k] = pack2(x3[2][e], x3[2][e + 1]); vg[k] = pack2(gv[e], gv[e + 1]);
        }
        *(u32x4*)(Rkk + o + hf * 8) = vkk; *(u32x4*)(Rka + o + hf * 8) = vka; *(u32x4*)(Rkp + o + hf * 8) = vkp;
        *(u32x4*)(Rr + o + hf * 8) = vr; *(u32x4*)(Rv + o + hf * 8) = vv; *(u32x4*)(Rg + o + hf * 8) = vg;
    }
    if (fq == 0) Rc[(size_t)R * 8 + h] = bon;
    __syncthreads();
}

__device__ __forceinline__ void delta_prep_row(KP p, int l, int R) {
    const int tid_ = tidx();
    const int lane = tid_ & 63;
    const bf16_t* P = (const bf16_t*)(p->ws + OFF_P);
    bf16_t* Dq = (bf16_t*)(p->ws + OFF_DQ); bf16_t* Dk = (bf16_t*)(p->ws + OFF_DK); bf16_t* Dv = (bf16_t*)(p->ws + OFF_DV);
    float* Dsc = (float*)(p->ws + OFF_DSC);
    int t, seq0, sb = 0; bool samp = R >= TPROMPT;
    if (!samp) { t = R & 2047; seq0 = R - t; } else { const int rs = R - TPROMPT; t = rs & 7; sb = rs >> 3; seq0 = R - t; }
    const float* cbuf = p->in[I_SCONV] + (size_t)(l * 128 + sb) * 3 * 1536;
    const float* cw = p->in[I_CONVW] + (size_t)l * 4 * 1536;
    const bool edge = samp || t < 3;
#pragma unroll 1
    for (int sg = 0; sg < 3; ++sg) {
        float va[4][2];
        if (!edge) {
#pragma unroll
            for (int s4 = 0; s4 < 4; ++s4) {
                const int c = (sg * 4 + s4) * 128 + lane * 2;
                unsigned u[4]; float2 w[4];
#pragma unroll
                for (int j = 0; j < 4; ++j) {
                    u[j] = *(const unsigned*)(P + (size_t)(R - 3 + j) * PW + PC + c);
                    w[j] = *(const float2*)(cw + (size_t)j * 1536 + c);
                }
                float a0 = 0.f, a1 = 0.f;
#pragma unroll
                for (int j = 0; j < 4; ++j) { a0 += lo2f(u[j]) * w[j].x; a1 += hi2f(u[j]) * w[j].y; }
                va[s4][0] = silu_(a0); va[s4][1] = silu_(a1);
            }
        } else {
#pragma unroll
            for (int s4 = 0; s4 < 4; ++s4) {
                const int c = (sg * 4 + s4) * 128 + lane * 2;
                unsigned u[4]; float2 w[4], f[4];
#pragma unroll
                for (int j = 0; j < 4; ++j) {
                    const int tau = t - 3 + j;
                    u[j] = *(const unsigned*)(P + (size_t)(seq0 + (tau >= 0 ? tau : 0)) * PW + PC + c);
                    int bi = 3 + tau; bi = bi < 0 ? 0 : (bi > 2 ? 2 : bi);
                    f[j] = *(const float2*)(cbuf + (size_t)bi * 1536 + c);
                    w[j] = *(const float2*)(cw + (size_t)j * 1536 + c);
                }
                float a0 = 0.f, a1 = 0.f;
#pragma unroll
                for (int j = 0; j < 4; ++j) {
                    const int tau = t - 3 + j;
                    const float x0 = tau >= 0 ? lo2f(u[j]) : (samp ? f[j].x : 0.f);
                    const float x1 = tau >= 0 ? hi2f(u[j]) : (samp ? f[j].y : 0.f);
                    a0 += x0 * w[j].x; a1 += x1 * w[j].y;
                }
                va[s4][0] = silu_(a0); va[s4][1] = silu_(a1);
            }
        }
        bf16_t* dst = sg == 0 ? Dq : (sg == 1 ? Dk : Dv);
#pragma unroll
        for (int s4 = 0; s4 < 4; ++s4) {
            float a0 = va[s4][0], a1 = va[s4][1];
            if (sg < 2) {
                const float ss = wave_sum(a0 * a0 + a1 * a1);
                float sc = rsqrtf(ss + 1e-12f);
                if (sg == 0) sc *= 0.08838834764831845f;
                a0 *= sc; a1 *= sc;
            }
            *(unsigned*)(dst + (size_t)R * 512 + s4 * 128 + lane * 2) = pack2(a0, a1);
        }
    }
    {
        bf16_t* SZ = (bf16_t*)(p->ws + OFF_SZ);
        unsigned zu[4];
#pragma unroll
        for (int hh = 0; hh < 4; ++hh) zu[hh] = *(const unsigned*)(P + (size_t)R * PW + PC + 1536 + hh * 128 + lane * 2);
#pragma unroll
        for (int hh = 0; hh < 4; ++hh) *(unsigned*)(SZ + (size_t)R * 512 + hh * 128 + lane * 2) = pack2(silu_(lo2f(zu[hh])), silu_(hi2f(zu[hh])));
    }
    if (lane < 4) {
        const float bb = bf2f(P[(size_t)R * PW + PBA + lane]);
        const float aa = bf2f(P[(size_t)R * PW + PBA + 4 + lane]);
        const float beta = sigmoid_(bb);
        const float g = -__expf(p->in[I_ALOG][l * 4 + lane]) * softplus_(aa + p->in[I_DTB][l * 4 + lane]);
        Dsc[((size_t)R * 4 + lane) * 2] = beta;
        Dsc[((size_t)R * 4 + lane) * 2 + 1] = __expf(g);
    }
}

__device__ __forceinline__ void delta_prep_quad(KP p, int l, int R0) {
    const int tid_ = tidx();
    const int lane = tid_ & 63;
    const bf16_t* P = (const bf16_t*)(p->ws + OFF_P);
    bf16_t* Dq = (bf16_t*)(p->ws + OFF_DQ); bf16_t* Dk = (bf16_t*)(p->ws + OFF_DK); bf16_t* Dv = (bf16_t*)(p->ws + OFF_DV);
    float* Dsc = (float*)(p->ws + OFF_DSC);
    bf16_t* SZ = (bf16_t*)(p->ws + OFF_SZ);
    const float* cw = p->in[I_CONVW] + (size_t)l * 4 * 1536;
#pragma unroll 1
    for (int sg = 0; sg < 3; ++sg) {
        unsigned u[4][7]; float2 w[4][4];
#pragma unroll
        for (int s4 = 0; s4 < 4; ++s4) {
            const int c = (sg * 4 + s4) * 128 + lane * 2;
#pragma unroll
            for (int r = 0; r < 7; ++r) u[s4][r] = *(const unsigned*)(P + (size_t)(R0 - 3 + r) * PW + PC + c);
#pragma unroll
            for (int j = 0; j < 4; ++j) w[s4][j] = *(const float2*)(cw + (size_t)j * 1536 + c);
        }
        float v0[4][4], v1[4][4];
#pragma unroll
        for (int tk = 0; tk < 4; ++tk)
#pragma unroll
            for (int s4 = 0; s4 < 4; ++s4) {
                float a0 = 0.f, a1 = 0.f;
#pragma unroll
                for (int j = 0; j < 4; ++j) { a0 += lo2f(u[s4][tk + j]) * w[s4][j].x; a1 += hi2f(u[s4][tk + j]) * w[s4][j].y; }
                v0[tk][s4] = silu_(a0); v1[tk][s4] = silu_(a1);
            }
        if (sg < 2) {
            float ss[4][4];
#pragma unroll
            for (int tk = 0; tk < 4; ++tk)
#pragma unroll
                for (int s4 = 0; s4 < 4; ++s4) ss[tk][s4] = red16(v0[tk][s4] * v0[tk][s4] + v1[tk][s4] * v1[tk][s4]);
#pragma unroll
            for (int tk = 0; tk < 4; ++tk)
#pragma unroll
                for (int s4 = 0; s4 < 4; ++s4) { float t = ss[tk][s4]; t += __shfl_xor(t, 16); ss[tk][s4] = t; }
#pragma unroll
            for (int tk = 0; tk < 4; ++tk)
#pragma unroll
                for (int s4 = 0; s4 < 4; ++s4) {
                    float t = ss[tk][s4]; t += __shfl_xor(t, 32);
                    float sc = rsqrtf(t + 1e-12f);
                    if (sg == 0) sc *= 0.08838834764831845f;
                    v0[tk][s4] *= sc; v1[tk][s4] *= sc;
                }
        }
        bf16_t* dst = sg == 0 ? Dq : (sg == 1 ? Dk : Dv);
#pragma unroll
        for (int tk = 0; tk < 4; ++tk)
#pragma unroll
            for (int s4 = 0; s4 < 4; ++s4)
                *(unsigned*)(dst + (size_t)(R0 + tk) * 512 + s4 * 128 + lane * 2) = pack2(v0[tk][s4], v1[tk][s4]);
    }
    {
        unsigned zu[4][4];
#pragma unroll
        for (int tk = 0; tk < 4; ++tk)
#pragma unroll
            for (int hh = 0; hh < 4; ++hh) zu[tk][hh] = *(const unsigned*)(P + (size_t)(R0 + tk) * PW + PC + 1536 + hh * 128 + lane * 2);
#pragma unroll
        for (int tk = 0; tk < 4; ++tk)
#pragma unroll
            for (int hh = 0; hh < 4; ++hh)
                *(unsigned*)(SZ + (size_t)(R0 + tk) * 512 + hh * 128 + lane * 2) = pack2(silu_(lo2f(zu[tk][hh])), silu_(hi2f(zu[tk][hh])));
    }
    if (lane < 16) {
        const int R = R0 + (lane >> 2), hh = lane & 3;
        const float bb = bf2f(P[(size_t)R * PW + PBA + hh]);
        const float aa = bf2f(P[(size_t)R * PW + PBA + 4 + hh]);
        const float g = -__expf(p->in[I_ALOG][l * 4 + hh]) * softplus_(aa + p->in[I_DTB][l * 4 + hh]);
        Dsc[((size_t)R * 4 + hh) * 2] = sigmoid_(bb);
        Dsc[((size_t)R * 4 + hh) * 2 + 1] = __expf(g);
    }
}

template <int W, bool EDGE>
__device__ __forceinline__ void pooled_item(const bf16_t* P, const float* pbuf, bf16_t* pooled, int R, int c, int t, int seq0, bool samp) {
    unsigned u[W]; float2 f[W];
#pragma unroll
    for (int q = 0; q < W; ++q) {
        const int tau = t - q;
        if (EDGE) {
            u[q] = *(const unsigned*)(P + (size_t)(seq0 + (tau >= 0 ? tau : 0)) * PW + PB + c);
            int bi = 15 + tau; bi = bi < 0 ? 0 : (bi > 14 ? 14 : bi);
            f[q] = *(const float2*)(pbuf + (size_t)bi * 512 + c);
        } else {
            u[q] = *(const unsigned*)(P + (size_t)(R - q) * PW + PB + c);
        }
    }
    float s0 = 0.f, s1 = 0.f;
#pragma unroll
    for (int q = 0; q < W; ++q) {
        const int tau = t - q;
        float x0 = lo2f(u[q]), x1 = hi2f(u[q]);
        if (EDGE) { if (tau < 0) { x0 = samp ? f[q].x : 0.f; x1 = samp ? f[q].y : 0.f; } }
        s0 += x0; s1 += x1;
    }
    const float cnt = samp ? (float)W : (float)(t + 1 < W ? t + 1 : W);
    *(unsigned*)(pooled + (size_t)R * 512 + c) = pack2(s0 / cnt - lo2f(u[0]), s1 / cnt - hi2f(u[0]));
}

template <int W>
__device__ __forceinline__ void pooled_blk16(const bf16_t* P, bf16_t* pooled, int R0, int c) {
    const int t0 = R0 & 2047;
    float x0[31], x1[31];
#pragma unroll
    for (int i = 0; i < 31; ++i) {
        x0[i] = 0.f; x1[i] = 0.f;
        if (i >= 16 - W) {
            const int tt = t0 - 15 + i;
            const unsigned v = *(const unsigned*)(P + (size_t)(tt >= 0 ? R0 - 15 + i : R0) * PW + PB + c);
            x0[i] = tt >= 0 ? lo2f(v) : 0.f; x1[i] = tt >= 0 ? hi2f(v) : 0.f;
        }
    }
#pragma unroll
    for (int i = 0; i < 16; ++i) {
        float s0 = 0.f, s1 = 0.f;
#pragma unroll
        for (int q = 0; q < W; ++q) { s0 += x0[15 + i - q]; s1 += x1[15 + i - q]; }
        const int t = t0 + i;
        const float inv = 1.f / (float)(t + 1 < W ? t + 1 : W);
        *(unsigned*)(pooled + (size_t)(R0 + i) * 512 + c) = pack2(s0 * inv - x0[15 + i], s1 * inv - x1[15 + i]);
    }
}

__device__ __forceinline__ void attn_block_task(KP p, int l, int k) {
    const int tid_ = tidx();
    const int wid = tid_ >> 6;
    const bf16_t* P = (const bf16_t*)(p->ws + OFF_P);
    bf16_t* BO = (bf16_t*)(p->ws + OFF_BO);
    const int t = k * 4 + wid;
    if (t < 4096 + 512) {
            int rowbase, nvalid, h; const bf16_t* kb; const bf16_t* vt;
            if (t < 4096) {
                const int qt = t & 127, b = t >> 9; h = (t >> 7) & 3;
                const size_t kvo = ((size_t)((l * 8 + b) * 4 + h)) * 16384;
                rowbase = b * 2048 + qt * 16; nvalid = 16;
                kb = (const bf16_t*)(p->ws + OFF_KP) + kvo; vt = (const bf16_t*)(p->ws + OFF_VTP) + kvo;
            } else {
                const int u = t - 4096, b = u >> 2; h = u & 3;
                const size_t kvo = ((size_t)(b * 4 + h)) * 16384;
                rowbase = TPROMPT + b * 8; nvalid = 8;
                kb = (const bf16_t*)(p->ws + OFF_KS) + kvo; vt = (const bf16_t*)(p->ws + OFF_VTS) + kvo;
            }
            attn_task(P, rowbase, nvalid, kb, vt, BO, h);
    }
}
__device__ __forceinline__ void misc_vblock(KP p, int l, int vb, int nvb) {
    const int tid_ = tidx();
    const int tid = tid_;
    const bf16_t* P = (const bf16_t*)(p->ws + OFF_P);
    const size_t gt = (size_t)vb * 256 + tid, gs = (size_t)nvb * 256;
    {
        bf16_t* pooled = (bf16_t*)(p->ws + OFF_POOLED);
        for (size_t i = gt; i < (size_t)(TPROMPT / 16) * 256; i += gs) {
            const int R0 = (int)(i >> 8) * 16, c = (int)(i & 255) * 2, w = 2 << (c >> 7);
            if (w == 2) pooled_blk16<2>(P, pooled, R0, c);
            else if (w == 4) pooled_blk16<4>(P, pooled, R0, c);
            else if (w == 8) pooled_blk16<8>(P, pooled, R0, c);
            else pooled_blk16<16>(P, pooled, R0, c);
        }
        for (size_t i = gt; i < (size_t)(NTOK - TPROMPT) * 256; i += gs) {
            const int R = TPROMPT + (int)(i >> 8), c = (int)(i & 255) * 2, w = 2 << (c >> 7);
            const int rs = R - TPROMPT, t = rs & 7, sb = rs >> 3, seq0 = R - t;
            const float* pbuf = p->in[I_SPOOL] + (size_t)(l * 128 + sb) * 15 * 512;
            if (w == 2) pooled_item<2, true>(P, pbuf, pooled, R, c, t, seq0, true);
            else if (w == 4) pooled_item<4, true>(P, pbuf, pooled, R, c, t, seq0, true);
            else if (w == 8) pooled_item<8, true>(P, pbuf, pooled, R, c, t, seq0, true);
            else pooled_item<16, true>(P, pbuf, pooled, R, c, t, seq0, true);
        }
    }
    {
        float* out = p->out;
        for (size_t i = gt; i < (size_t)136 * 448; i += gs) {
            const int sq = (int)(i / 448), c = (int)(i % 448) * 4;
            const int row = sq < 8 ? sq * 2048 + 2047 : TPROMPT + (sq - 8) * 8 + 7;
            const uint2 u = *(const uint2*)(P + (size_t)row * PW + c);
            float* dst = sq < 8 ? out + O_PSHIFT + (size_t)(l * 8 + sq) * 1792 + c : out + O_SSHIFT + (size_t)(l * 128 + sq - 8) * 1792 + c;
            *(float4*)dst = make_float4(lo2f(u.x), hi2f(u.x), lo2f(u.y), hi2f(u.y));
        }
        for (size_t i = gt; i < (size_t)136 * 15 * 128; i += gs) {
            const int c = (int)(i & 127) * 4, r = (int)((i >> 7) % 15), sq = (int)((i >> 7) / 15);
            const int b = sq < 8 ? 0 : sq - 8;
            const int row = sq < 8 ? sq * 2048 + 2033 + r : TPROMPT + b * 8 + (r >= 7 ? r - 7 : 0);
            const uint2 u = *(const uint2*)(P + (size_t)row * PW + PB + c);
            const float4 sp = *(const float4*)(p->in[I_SPOOL] + ((size_t)(l * 128 + b) * 15 + (r < 7 ? 8 + r : 0)) * 512 + c);
            float4 v = make_float4(lo2f(u.x), hi2f(u.x), lo2f(u.y), hi2f(u.y));
            if (sq >= 8 && r < 7) v = sp;
            float* dst = sq < 8 ? out + O_PPOOL + ((size_t)(l * 8 + sq) * 15 + r) * 512 + c : out + O_SPOOL + ((size_t)(l * 128 + b) * 15 + r) * 512 + c;
            *(float4*)dst = v;
        }
        for (size_t i = gt; i < (size_t)136 * 3 * 384; i += gs) {
            const int c = (int)(i % 384) * 4, r = (int)((i / 384) % 3), sq = (int)(i / (3 * 384));
            const int row = sq < 8 ? sq * 2048 + 2045 + r : TPROMPT + (sq - 8) * 8 + 5 + r;
            const uint2 u = *(const uint2*)(P + (size_t)row * PW + PC + c);
            float* dst = sq < 8 ? out + O_PCONV + ((size_t)(l * 8 + sq) * 3 + r) * 1536 + c : out + O_SCONV + ((size_t)(l * 128 + sq - 8) * 3 + r) * 1536 + c;
            *(float4*)dst = make_float4(lo2f(u.x), hi2f(u.x), lo2f(u.y), hi2f(u.y));
        }
    }
}
__device__ __forceinline__ void phase_prep(KP p, int l, unsigned char* smem) {
    const int tid_ = tidx();
    const int wid = tid_ >> 6;
    for (int t = blockIdx.x; t < 1088 * 2; t += gridDim.x) rwkv_prep_task(p, l, t >> 1, t & 1, (bf16_t*)smem);
    const int gw = blockIdx.x * 4 + wid, nw = gridDim.x * 4;
    for (int q = gw; q < TPROMPT / 4 + (NTOK - TPROMPT); q += nw) {
        if (q < TPROMPT / 4) {
            const int R0 = q * 4;
            if ((R0 & 2047) == 0) { for (int k = 0; k < 4; ++k) delta_prep_row(p, l, R0 + k); }
            else delta_prep_quad(p, l, R0);
        } else delta_prep_row(p, l, TPROMPT + (q - TPROMPT / 4));
    }
}

typedef float f32x2 __attribute__((ext_vector_type(2)));
__device__ __forceinline__ float red8(float v) {
    v += dpp_mov<0xB1>(v);
    v += dpp_mov<0x4E>(v);
    v += dpp_mov<0x141>(v);
    return v;
}
__device__ __forceinline__ void rwkv_scan_task(KP p, int l, bool samp, int b, int h, int hb, float* sm) {
    const int tid_ = tidx();
    const int tid = tid_, lane = tid & 63, wid = tid >> 6, rr = lane >> 3, ks = lane & 7;
    const int L = samp ? 8 : 2048, row0 = samp ? TPROMPT + b * 8 : b * 2048;
    const int vrow = hb * 32 + wid * 8 + rr;
    const float* Rw = (const float*)(p->ws + OFF_RW);
    const bf16_t* Rkk = (const bf16_t*)(p->ws + OFF_RKK); const bf16_t* Rka = (const bf16_t*)(p->ws + OFF_RKA);
    const bf16_t* Rkp = (const bf16_t*)(p->ws + OFF_RKP); const bf16_t* Rr = (const bf16_t*)(p->ws + OFF_RR);
    const bf16_t* Rv = (const bf16_t*)(p->ws + OFF_RV);
    float* yraw = (float*)(p->ws + OFF_Y);
    f32x2 S[4];
#pragma unroll
    for (int i = 0; i < 4; ++i) S[i] = (f32x2){0.f, 0.f};
    if (samp) {
        const float* sp = p->in[I_SRWKV] + ((size_t)((l * 128 + b) * 8 + h) * 64 + vrow) * 64 + ks * 8;
        const float4 s0 = *(const float4*)sp, s1 = *(const float4*)(sp + 4);
        S[0] = (f32x2){s0.x, s0.y}; S[1] = (f32x2){s0.z, s0.w}; S[2] = (f32x2){s1.x, s1.y}; S[3] = (f32x2){s1.z, s1.w};
    }
    const int sstep = tid >> 4, sc = tid & 15;
    float4 pw; uint2 pkk, pka, pkp, pr; unsigned pv;
    const int ntile = (L + 15) >> 4;
    auto load_tile = [&](int tile) {
        const int step = tile * 16 + sstep;
        if (step < L) {
            const size_t o = (size_t)(row0 + step) * 512 + h * 64 + sc * 4;
            pw = *(const float4*)(Rw + o);
            pkk = *(const uint2*)(Rkk + o); pka = *(const uint2*)(Rka + o); pkp = *(const uint2*)(Rkp + o); pr = *(const uint2*)(Rr + o);
            pv = *(const unsigned*)(Rv + (size_t)(row0 + step) * 512 + h * 64 + hb * 32 + sc * 2);
        }
    };
    load_tile(0);
    for (int tile = 0; tile < ntile; ++tile) {
        float* bufp = sm + (tile & 1) * 5632;
        {
            const int o = sstep * 64 + sc * 4;
            *(float4*)(bufp + o) = pw;
            *(float4*)(bufp + 1024 + o) = make_float4(lo2f(pkk.x), hi2f(pkk.x), lo2f(pkk.y), hi2f(pkk.y));
            *(float4*)(bufp + 2048 + o) = make_float4(lo2f(pka.x), hi2f(pka.x), lo2f(pka.y), hi2f(pka.y));
            *(float4*)(bufp + 3072 + o) = make_float4(lo2f(pkp.x), hi2f(pkp.x), lo2f(pkp.y), hi2f(pkp.y));
            *(float4*)(bufp + 4096 + o) = make_float4(lo2f(pr.x), hi2f(pr.x), lo2f(pr.y), hi2f(pr.y));
            *(float2*)(bufp + 5120 + sstep * 32 + sc * 2) = make_float2(lo2f(pv), hi2f(pv));
        }
        __syncthreads();
        if (tile + 1 < ntile) load_tile(tile + 1);
        const int nst = (L - tile * 16) < 16 ? (L - tile * 16) : 16;
        for (int s0 = 0; s0 < nst; s0 += 4) {
#pragma unroll
            for (int s4 = 0; s4 < 4; ++s4) {
                const int s = s0 + s4;
                const float* bs = bufp + s * 64 + ks * 8;
                f32x2 w2[4], kk2[4], ka2[4], kp2[4], r2[4];
#pragma unroll
                for (int hh = 0; hh < 2; ++hh) {
                    const float4 a = *(const float4*)(bs + hh * 4);
                    const float4 bq = *(const float4*)(bs + 1024 + hh * 4);
                    const float4 c = *(const float4*)(bs + 2048 + hh * 4);
                    const float4 d = *(const float4*)(bs + 3072 + hh * 4);
                    const float4 e = *(const float4*)(bs + 4096 + hh * 4);
                    w2[2 * hh] = (f32x2){a.x, a.y}; w2[2 * hh + 1] = (f32x2){a.z, a.w};
                    kk2[2 * hh] = (f32x2){bq.x, bq.y}; kk2[2 * hh + 1] = (f32x2){bq.z, bq.w};
                    ka2[2 * hh] = (f32x2){c.x, c.y}; ka2[2 * hh + 1] = (f32x2){c.z, c.w};
                    kp2[2 * hh] = (f32x2){d.x, d.y}; kp2[2 * hh + 1] = (f32x2){d.z, d.w};
                    r2[2 * hh] = (f32x2){e.x, e.y}; r2[2 * hh + 1] = (f32x2){e.z, e.w};
                }
                const float vv = bufp[5120 + s * 32 + wid * 8 + rr];
                const f32x2 vv2 = (f32x2){vv, vv};
                f32x2 da = S[0] * kk2[0], db = S[1] * kk2[1];
                da = S[2] * kk2[2] + da; db = S[3] * kk2[3] + db;
                da = da + db;
                f32x2 u2[4];
#pragma unroll
                for (int i = 0; i < 4; ++i) u2[i] = S[i] * w2[i] + vv2 * kp2[i];
                const float d1 = red8(da.x + da.y);
                const f32x2 nd = (f32x2){-d1, -d1};
#pragma unroll
                for (int i = 0; i < 4; ++i) S[i] = nd * ka2[i] + u2[i];
                f32x2 ya = S[0] * r2[0], yb = S[1] * r2[1];
                ya = S[2] * r2[2] + ya; yb = S[3] * r2[3] + yb;
                ya = ya + yb;
                const float y = red8(ya.x + ya.y);
                yraw[(size_t)(row0 + tile * 16 + s) * 512 + h * 64 + vrow] = y;
            }
        }
    }
    float* so = (samp ? p->out + O_SRWKV + ((size_t)((l * 128 + b) * 8 + h) * 64 + vrow) * 64
                      : p->out + O_PRWKV + ((size_t)((l * 8 + b) * 8 + h) * 64 + vrow) * 64) + ks * 8;
    *(float4*)so = make_float4(S[0].x, S[0].y, S[1].x, S[1].y);
    *(float4*)(so + 4) = make_float4(S[2].x, S[2].y, S[3].x, S[3].y);
    __syncthreads();
}

__device__ __forceinline__ void delta_scan_task(KP p, int l, bool samp, int b, int h, int cgp, float* sm) {
    const int tid_ = tidx();
    const int tid = tid_, lane = tid & 63, wid = tid >> 6, cc = lane >> 3, ks = lane & 7;
    const int L = samp ? 8 : 2048, row0 = samp ? TPROMPT + b * 8 : b * 2048;
    const int e = cgp * 32 + wid * 8 + cc;
    const bf16_t* Dq = (const bf16_t*)(p->ws + OFF_DQ); const bf16_t* Dk = (const bf16_t*)(p->ws + OFF_DK); const bf16_t* Dv = (const bf16_t*)(p->ws + OFF_DV);
    const float* Dsc = (const float*)(p->ws + OFF_DSC);
    float* oraw = (float*)(p->ws + OFF_Y) + (size_t)NTOK * 512;
    f32x2 S[8];
    const size_t sbase = samp ? ((size_t)((l * 128 + b) * 4 + h) * 128) * 128 : ((size_t)((l * 8 + b) * 4 + h) * 128) * 128;
#pragma unroll
    for (int j = 0; j < 8; ++j) {
        S[j] = (f32x2){0.f, 0.f};
        if (samp) {
            S[j].x = p->in[I_SDELTA][sbase + (size_t)(ks * 16 + 2 * j) * 128 + e];
            S[j].y = p->in[I_SDELTA][sbase + (size_t)(ks * 16 + 2 * j + 1) * 128 + e];
        }
    }
    const int sstep = tid >> 4, sc = tid & 15;
    uint4 pk, pq; unsigned pv; float2 psc;
    const int ntile = (L + 15) >> 4;
    auto load_tile = [&](int tile) {
        const int step = tile * 16 + sstep;
        if (step < L) {
            const size_t o = (size_t)(row0 + step) * 512 + h * 128 + sc * 8;
            pk = *(const uint4*)(Dk + o); pq = *(const uint4*)(Dq + o);
            pv = *(const unsigned*)(Dv + (size_t)(row0 + step) * 512 + h * 128 + cgp * 32 + sc * 2);
        }
        if (tid < 16 && tile * 16 + tid < L) psc = *(const float2*)(Dsc + ((size_t)(row0 + tile * 16 + tid) * 4 + h) * 2);
    };
    load_tile(0);
    for (int tile = 0; tile < ntile; ++tile) {
        float* bufp = sm + (tile & 1) * 4640;
        {
            const int o = sstep * 128 + sc * 8;
            *(float4*)(bufp + o) = make_float4(lo2f(pk.x), hi2f(pk.x), lo2f(pk.y), hi2f(pk.y));
            *(float4*)(bufp + o + 4) = make_float4(lo2f(pk.z), hi2f(pk.z), lo2f(pk.w), hi2f(pk.w));
            *(float4*)(bufp + 2048 + o) = make_float4(lo2f(pq.x), hi2f(pq.x), lo2f(pq.y), hi2f(pq.y));
            *(float4*)(bufp + 2048 + o + 4) = make_float4(lo2f(pq.z), hi2f(pq.z), lo2f(pq.w), hi2f(pq.w));
            *(float2*)(bufp + 4096 + sstep * 32 + sc * 2) = make_float2(lo2f(pv), hi2f(pv));
            if (tid < 16) { bufp[4608 + tid] = psc.x; bufp[4624 + tid] = psc.y; }
        }
        __syncthreads();
        if (tile + 1 < ntile) load_tile(tile + 1);
        const int nst = (L - tile * 16) < 16 ? (L - tile * 16) : 16;
        for (int s0 = 0; s0 < nst; s0 += 4) {
#pragma unroll
            for (int s4 = 0; s4 < 4; ++s4) {
                const int s = s0 + s4;
                f32x2 k2[8], q2[8];
#pragma unroll
                for (int hh = 0; hh < 4; ++hh) {
                    const float4 a = *(const float4*)(bufp + s * 128 + ks * 16 + hh * 4);
                    const float4 c = *(const float4*)(bufp + 2048 + s * 128 + ks * 16 + hh * 4);
                    k2[2 * hh] = (f32x2){a.x, a.y}; k2[2 * hh + 1] = (f32x2){a.z, a.w};
                    q2[2 * hh] = (f32x2){c.x, c.y}; q2[2 * hh + 1] = (f32x2){c.z, c.w};
                }
                const float vv = bufp[4096 + s * 32 + wid * 8 + cc];
                const float beta = bufp[4608 + s], alpha = bufp[4624 + s];
                f32x2 d0 = S[0] * k2[0], d1v = S[1] * k2[1], d2 = S[2] * k2[2], d3 = S[3] * k2[3];
                d0 = S[4] * k2[4] + d0; d1v = S[5] * k2[5] + d1v; d2 = S[6] * k2[6] + d2; d3 = S[7] * k2[7] + d3;
                d0 = (d0 + d1v) + (d2 + d3);
                const f32x2 al2 = (f32x2){alpha, alpha};
                f32x2 sa[8];
#pragma unroll
                for (int j = 0; j < 8; ++j) sa[j] = S[j] * al2;
                const float dk = red8(d0.x + d0.y);
                const float vn = beta * (vv - alpha * dk);
                const f32x2 vn2 = (f32x2){vn, vn};
#pragma unroll
                for (int j = 0; j < 8; ++j) S[j] = k2[j] * vn2 + sa[j];
                f32x2 o0 = S[0] * q2[0], o1 = S[1] * q2[1], o2 = S[2] * q2[2], o3 = S[3] * q2[3];
                o0 = S[4] * q2[4] + o0; o1 = S[5] * q2[5] + o1; o2 = S[6] * q2[6] + o2; o3 = S[7] * q2[7] + o3;
                o0 = (o0 + o1) + (o2 + o3);
                const float o = red8(o0.x + o0.y);
                oraw[(size_t)(row0 + tile * 16 + s) * 512 + h * 128 + e] = o;
            }
        }
    }
    float* so = (samp ? p->out + O_SDELTA : p->out + O_PDELTA) + sbase;
#pragma unroll
    for (int j = 0; j < 8; ++j) {
        so[(size_t)(ks * 16 + 2 * j) * 128 + e] = S[j].x;
        so[(size_t)(ks * 16 + 2 * j + 1) * 128 + e] = S[j].y;
    }
    __syncthreads();
}

__device__ __forceinline__ void phase_scan(KP p, int l, unsigned char* smem) {
    __shared__ int s_q;
    const int tid_ = tidx();
    const int NLONG = 256, NT_RS = 2048, NT_DS = 2048;
    const int G = gridDim.x, bid = blockIdx.x;
    const bool split = G >= 2 * NLONG;
    if (split && bid < NLONG) {
        if (bid < 128) rwkv_scan_task(p, l, false, bid >> 4, (bid >> 1) & 7, bid & 1, (float*)smem);
        else { const int u = bid - 128; delta_scan_task(p, l, false, u >> 4, (u >> 2) & 3, u & 3, (float*)smem); }
    } else {
        const int first = split ? bid - NLONG : bid, stride = split ? G - NLONG : G;
        const int total = (split ? 0 : NLONG) + NT_RS + NT_DS;
        for (int t = first; t < total; t += stride) {
            int u = t;
            if (!split) {
                if (u < 128) { rwkv_scan_task(p, l, false, u >> 4, (u >> 1) & 7, u & 1, (float*)smem); continue; }
                if (u < 256) { const int v = u - 128; delta_scan_task(p, l, false, v >> 4, (v >> 2) & 3, v & 3, (float*)smem); continue; }
                u -= NLONG;
            }
            if (u < NT_RS) { rwkv_scan_task(p, l, true, u >> 4, (u >> 1) & 7, u & 1, (float*)smem); continue; }
            u -= NT_RS;
            delta_scan_task(p, l, true, u >> 4, (u >> 2) & 3, u & 3, (float*)smem);
        }
    }
    unsigned* cnt = (unsigned*)(p->ws + OFF_CNT) + l * 64;
    for (;;) {
        __syncthreads();
        if (tid_ == 0) s_q = (int)atomicAdd(cnt, 1u);
        __syncthreads();
        const int t = s_q;
        const int NGT = 136 * 32, NAT = 1152, NMV = 256;
        if (t >= NGT + NAT + NMV) break;
        if (t < NMV) misc_vblock(p, l, t, NMV);
        else if (t < NMV + NAT) attn_block_task(p, l, t - NMV);
        else gate_tile(t - NMV - NAT, (const bf16_t*)(p->ws + OFF_XB), (const bf16_t*)(p->ws + OFF_WG), (bf16_t*)(p->ws + OFF_G), (bf16_t*)smem);
    }
}

__device__ __forceinline__ void phase_post(KP p, int l, unsigned char* smem) {
    for (int t = blockIdx.x; t < 544; t += gridDim.x) {
        pool_gemm_tile(t, (const bf16_t*)(p->ws + OFF_POOLED), (const bf16_t*)(p->ws + OFF_POOLT), p->in[I_POOLS] + l * 512,
                       (bf16_t*)(p->ws + OFF_BO), (bf16_t*)smem);
        __syncthreads();
    }
    const int tid_ = tidx();
    const int lane = tid_ & 63, wid = tid_ >> 6;
    bf16_t* BO = (bf16_t*)(p->ws + OFF_BO);
    const float* yraw = (const float*)(p->ws + OFF_Y);
    const float* oraw = yraw + (size_t)NTOK * 512;
    const bf16_t* Rv = (const bf16_t*)(p->ws + OFF_RV); const bf16_t* Rg = (const bf16_t*)(p->ws + OFF_RG);
    const bf16_t* SZ = (const bf16_t*)(p->ws + OFF_SZ);
    const float* Rc = (const float*)(p->ws + OFF_RC);
    const int c0 = lane * 8;
    float gw[8], gb[8], nw[8];
    {
        const float4 a = *(const float4*)(p->in[I_GNW] + l * 512 + c0), a2 = *(const float4*)(p->in[I_GNW] + l * 512 + c0 + 4);
        const float4 bq = *(const float4*)(p->in[I_GNB] + l * 512 + c0), b2 = *(const float4*)(p->in[I_GNB] + l * 512 + c0 + 4);
        const float4 n1 = *(const float4*)(p->in[I_NORMW] + l * 128 + (c0 & 127)), n2 = *(const float4*)(p->in[I_NORMW] + l * 128 + (c0 & 127) + 4);
        gw[0] = a.x; gw[1] = a.y; gw[2] = a.z; gw[3] = a.w; gw[4] = a2.x; gw[5] = a2.y; gw[6] = a2.z; gw[7] = a2.w;
        gb[0] = bq.x; gb[1] = bq.y; gb[2] = bq.z; gb[3] = bq.w; gb[4] = b2.x; gb[5] = b2.y; gb[6] = b2.z; gb[7] = b2.w;
        nw[0] = n1.x; nw[1] = n1.y; nw[2] = n1.z; nw[3] = n1.w; nw[4] = n2.x; nw[5] = n2.y; nw[6] = n2.z; nw[7] = n2.w;
    }
    for (int R = blockIdx.x * 4 + wid; R < NTOK; R += gridDim.x * 4) {
        const size_t o = (size_t)R * 512 + c0;
        const float4 y0 = ldnt4(yraw + o), y1 = ldnt4(yraw + o + 4);
        const float4 d0 = ldnt4(oraw + o), d1 = ldnt4(oraw + o + 4);
        const u32x4 rv = *(const u32x4*)(Rv + o), rg = ldntu4(Rg + o), sz = ldntu4(SZ + o);
        const float bon = Rc[(size_t)R * 8 + (lane >> 3)];
        float y[8] = {y0.x, y0.y, y0.z, y0.w, y1.x, y1.y, y1.z, y1.w};
        float dl[8] = {d0.x, d0.y, d0.z, d0.w, d1.x, d1.y, d1.z, d1.w};
        float s = 0.f;
#pragma unroll
        for (int j = 0; j < 8; ++j) s += y[j];
        const float mean = red8(s) * (1.f / 64.f);
        float q = 0.f, dq = 0.f;
#pragma unroll
        for (int j = 0; j < 8; ++j) { y[j] -= mean; q += y[j] * y[j]; dq += dl[j] * dl[j]; }
        const float rstd = rsqrtf(red8(q) * (1.f / 64.f) + 64e-5f);
        const float rs = rsqrtf(red16(dq) * (1.f / 128.f) + 1e-6f);
        float oa[8], oc[8];
#pragma unroll
        for (int j = 0; j < 8; ++j) {
            const unsigned vu = rv[j >> 1], gu = rg[j >> 1], zu = sz[j >> 1];
            const float vv = (j & 1) ? hi2f(vu) : lo2f(vu), gg = (j & 1) ? hi2f(gu) : lo2f(gu), zz = (j & 1) ? hi2f(zu) : lo2f(zu);
            oa[j] = (y[j] * rstd * gw[j] + gb[j] + bon * vv) * gg;
            oc[j] = dl[j] * rs * nw[j] * zz;
        }
        u32x4 pa, pc;
#pragma unroll
        for (int j = 0; j < 4; ++j) { pa[j] = pack2(oa[2 * j], oa[2 * j + 1]); pc[j] = pack2(oc[2 * j], oc[2 * j + 1]); }
        *(u32x4*)(BO + (size_t)R * 1792 + c0) = pa;
        *(u32x4*)(BO + (size_t)R * 1792 + 1024 + c0) = pc;
    }
}

__device__ __forceinline__ void run_phase(KP p, int ph, unsigned char* smem) {
    unsigned char* ws = p->ws;
    bf16_t* xb = (bf16_t*)(ws + OFF_XB);
    float* X = p->out;
    float* Y = (float*)(ws + OFF_Y);
    bf16_t* P = (bf16_t*)(ws + OFF_P);
    bf16_t* H = P;
    const bool init = ph == 0;
    const int l = init ? 0 : (ph - 1) / NPH_LAYER, s = init ? -1 : (ph - 1) % NPH_LAYER;
    if (s == 0 || s == 10) {
        phase_ffn_in(xb, (const bf16_t*)(ws + (s == 0 ? OFF_WF1I : OFF_WF2I)), H, (bf16_t*)smem);
        if (s == 0 && l == 0) phase_memkv(p, (bf16_t*)smem);
    } else if (s == 1 || s == 8 || s == 11) {
        const bf16_t* A = s == 8 ? (const bf16_t*)(ws + OFF_MERGED) : H;
        const int K = s == 8 ? 1024 : 2048;
        const bf16_t* W = (const bf16_t*)(ws + (s == 1 ? OFF_WF1O : (s == 8 ? OFF_WO : OFF_WF2O)));
        phase_gemm_resid(A, K, K, W, X, Y, s == 8 ? 1.0f : 0.5f, (bf16_t*)smem);
    } else if (init || s == 2 || s == 9 || s == 12) {
        if (!init) {
            const int li = s == 2 ? 0 : (s == 9 ? 1 : 2);
            phase_ln(Y, X, xb, p->in[I_LNG] + (l * 3 + li) * 1024, p->in[I_LNB] + (l * 3 + li) * 1024);
        }
        if (s == 2) conv_sample_kv(p, l);
        if (init) phase_init(p, (float*)smem);
        if (init || (s == 12 && l < 3)) convert_layer_weights(p, init ? 0 : l + 1, (float*)smem);
    } else if (s == 3) {
        phase_proj(xb, (const bf16_t*)(ws + OFF_WP), P, (bf16_t*)smem);
    } else if (s == 4) {
        phase_prep(p, l, smem);
    } else if (s == 5) {
        phase_scan(p, l, smem);
    } else if (s == 6) {
        phase_post(p, l, smem);
    } else {
        phase_merge((const bf16_t*)(ws + OFF_G), (const bf16_t*)(ws + OFF_BO), (const bf16_t*)(ws + OFF_WB), (bf16_t*)(ws + OFF_MERGED), (bf16_t*)smem);
    }
}

#define XB_TMO      128
#define XB_XCNT(j)  (256  + 64 * (j))
#define XB_XSUB(j)  (1280 + 64 * (j))
#define XB_XGEN(j)  (2304 + 64 * (j))
#define XB_TOP      3328
#define XB_TOPGEN   3392
#define XCD_BAR_WORDS 3456
#define XB_SPIN_CAP (1u << 22)
#define LAS __attribute__((address_space(3)))
__device__ __forceinline__ unsigned xb_ld(unsigned* p)              { return __hip_atomic_load(p, __ATOMIC_RELAXED, __HIP_MEMORY_SCOPE_AGENT); }
__device__ __forceinline__ unsigned xb_add(unsigned* p, unsigned v) { return __hip_atomic_fetch_add(p, v, __ATOMIC_RELAXED, __HIP_MEMORY_SCOPE_AGENT); }
__device__ __forceinline__ unsigned xb_xcc_id() { return (unsigned)__builtin_amdgcn_s_getreg((3 << 11) | 20) & 0xFu; }
#define XB_SPIN(cond, bar) do { unsigned _sp = 0; while (cond) { __builtin_amdgcn_s_sleep(1); \
    if ((++_sp & 255u) == 0u) { if (xb_ld(&(bar)[XB_TMO])) break; if (_sp > XB_SPIN_CAP) { atomicAdd(&(bar)[XB_TMO], 1u); break; } } } } while (0)
struct XcdBarrier { unsigned* bar; unsigned x; volatile LAS unsigned* st; };
__device__ __forceinline__ XcdBarrier xcd_barrier_post(unsigned* bar, volatile LAS unsigned* st) {
    XcdBarrier b; b.bar = bar; b.x = xb_xcc_id(); b.st = st;
    if (threadIdx.x == 0) (void)xb_add(&bar[XB_XCNT(b.x)], 1u);
    return b;
}
__device__ __forceinline__ void xcd_barrier_complete(unsigned* bar, unsigned x, unsigned& nloc, unsigned& nx) {
    const unsigned G = gridDim.x * gridDim.y * gridDim.z;
    unsigned sum, cnt, mine, sp = 0u;
    for (;;) {
        sum = 0u; cnt = 0u; mine = 0u;
#pragma unroll
        for (unsigned j = 0; j < 16; ++j) { const unsigned c = xb_ld(&bar[XB_XCNT(j)]); sum += c; cnt += (c > 0u) ? 1u : 0u; mine = (j == x) ? c : mine; }
        if (sum == G) break;
        __builtin_amdgcn_s_sleep(1);
        if ((++sp & 255u) == 0u) { if (xb_ld(&bar[XB_TMO])) break; if (sp > XB_SPIN_CAP) { atomicAdd(&bar[XB_TMO], 1u); break; } }
    }
    nloc = mine > 0u ? mine : 1u; nx = cnt > 0u ? cnt : 1u;
}
__device__ __forceinline__ void xcd_barrier(const XcdBarrier& b) {
    asm volatile("s_waitcnt vmcnt(0)" ::: "memory");
    __syncthreads();
    if (threadIdx.x == 0) {
        unsigned* bar = b.bar;
        __builtin_amdgcn_s_waitcnt(0);
        unsigned nloc = b.st[0], nx = b.st[1];
        if (nloc == 0u) { xcd_barrier_complete(bar, b.x, nloc, nx); b.st[0] = nloc; b.st[1] = nx; }
        const unsigned old = xb_add(&bar[XB_XSUB(b.x)], 1u);
        const unsigned gen = old / nloc;
        if (old + 1u == (gen + 1u) * nloc) {
            __builtin_amdgcn_fence(__ATOMIC_RELEASE, "agent");
            asm volatile("s_waitcnt vmcnt(0)" ::: "memory");
            const unsigned og = xb_add(&bar[XB_TOP], 1u);
            const unsigned tg = og / nx;
            if (og + 1u == (tg + 1u) * nx) xb_add(&bar[XB_TOPGEN], 1u);
            else XB_SPIN(xb_ld(&bar[XB_TOPGEN]) == tg, bar);
            __builtin_amdgcn_fence(__ATOMIC_ACQUIRE, "agent");
            xb_add(&bar[XB_XGEN(b.x)], 1u);
            asm volatile("s_waitcnt vmcnt(0)" ::: "memory");
        } else {
            XB_SPIN(xb_ld(&bar[XB_XGEN(b.x)]) == gen, bar);
            __builtin_amdgcn_fence(__ATOMIC_ACQUIRE, "agent");
            asm volatile("s_waitcnt vmcnt(0)" ::: "memory");
        }
    }
    __syncthreads();
}

__global__ void __launch_bounds__(256, 2) mega(Params p, int ph_lo, int ph_hi) {
    __shared__ __attribute__((aligned(16))) unsigned char smem[45056];
    __shared__ uint4 xb_words;
    cg::grid_group grid = cg::this_grid();
    if (threadIdx.x == 0) xb_words = make_uint4(0u, 0u, 0u, 0u);
    __syncthreads();
    KP kp0 = (KP)__builtin_amdgcn_kernarg_segment_ptr();
    XcdBarrier xb = xcd_barrier_post((unsigned*)(kp0->ws + OFF_BAR), (volatile LAS unsigned*)&xb_words);
    if (ph_hi > 100000) grid.sync();
    for (int ph = ph_lo; ph < ph_hi; ++ph) {
#ifdef REPEAT_MASK
        const int nrep = (ph > 0 && ((REPEAT_MASK >> ((ph - 1) % NPH_LAYER)) & 1)) ? 2 : 1;
        for (int rep = 0; rep < nrep; ++rep)
#endif
        { KP kq = kp0; asm volatile("" : "+s"(kq)); run_phase(kq, ph, smem); }
        if (ph + 1 < ph_hi) xcd_barrier(xb);
    }
}

extern "C" void kernel_launch(void* const* d_in, const int* in_sizes, int n_in, void* d_out, int out_size, void* d_ws, size_t ws_size,
                              hipStream_t stream) {
    Params p{};
    for (int i = 0; i < 37; ++i) p.in[i] = (const float*)d_in[i];
    p.out = (float*)d_out; p.ws = (unsigned char*)d_ws;
    static int grid_blocks = 0;
    if (!grid_blocks) {
        int dev = 0, cus = 0, per_cu = 0;
        hipGetDevice(&dev);
        hipDeviceGetAttribute(&cus, hipDeviceAttributeMultiprocessorCount, dev);
        hipOccupancyMaxActiveBlocksPerMultiprocessor(&per_cu, mega, 256, 0);
        if (per_cu > 2) per_cu = 2;
        if (per_cu < 1) per_cu = 1;
        grid_blocks = cus * per_cu;
    }
    if (ws_size < WS_TOTAL) { fprintf(stderr, "workspace too small\n"); return; }
    (void)hipMemsetAsync((unsigned char*)d_ws + OFF_BAR, 0, (OFF_CNT - OFF_BAR) + 1024, stream);
#if MULTI_LAUNCH
    for (int ph = 0; ph < NPHASES; ++ph) {
        int lo = ph, hi = ph + 1;
        hipLaunchKernelGGL(mega, dim3(grid_blocks), dim3(256), 0, stream, p, lo, hi);
    }
#else
    int lo = 0, hi = NPHASES;
    void* args[] = {&p, &lo, &hi};
    hipError_t e = hipLaunchCooperativeKernel((void*)mega, dim3(grid_blocks), dim3(256), args, 0, stream);
    if (e != hipSuccess) fprintf(stderr, "cooperative launch failed: %s (grid %d)\n", hipGetErrorString(e), grid_blocks);
#endif
}
```
